# Optimizing an MI355X kernel written in HIP

```python
import jax, jax.numpy as jnp
from jax import lax
import numpy as np

D_MODEL = 1024
BATCH = 8
SEQ = 2048
DEPTH = 4

CTX_LEN = 256
GRID_W = 64
N_MIXERS = 3
WIDTH = D_MODEL
POOL_WINDOWS = (2, 4, 8, 16)
N_POOL_GROUPS = 4
POOL_GROUP = WIDTH // N_POOL_GROUPS
HEAD_DIM = 64
N_HEADS = WIDTH // HEAD_DIM
WIN_ROWS_MAX = 8
WIN_COLS = 16
CONV_WIDTH = 3
EPS = 1e-6
N_POOL_LAYERS = (DEPTH + 2) // 3
N_NA_LAYERS = (DEPTH + 1) // 3
N_CONV_LAYERS = DEPTH // 3

kernel_name = "hybrid_pool_natten_shortconv_dit"


def _rmsnorm(x, g):
    xf = x.astype(jnp.float32)
    y = xf * lax.rsqrt(jnp.mean(xf * xf, axis=-1, keepdims=True) + EPS)
    return (y * g.astype(jnp.float32)).astype(x.dtype)


def _modulation(cond, w, b):
    m = jax.nn.silu(cond) @ w + b
    return jnp.split(m, 3, axis=-1)


def _centred_mean(u, w):
    b_, l_, c_ = u.shape
    cs = jnp.concatenate([jnp.zeros((b_, 1, c_), jnp.float32),
                          jnp.cumsum(u.astype(jnp.float32), axis=1)], axis=1)
    t = jnp.arange(l_)
    lo = jnp.clip(t - w // 2, 0, l_)
    hi = jnp.clip(t + w // 2, 0, l_)
    cnt = (hi - lo).astype(jnp.float32)
    return ((cs[:, hi] - cs[:, lo]) / cnt[None, :, None]).astype(u.dtype)


def _pool_mixer(h, w_in, w_grp, scale, w_out):
    u, g = jnp.split(h @ w_in, 2, axis=-1)
    b_, l_, _ = u.shape
    ug = u.reshape(b_, l_, N_POOL_GROUPS, POOL_GROUP)
    pooled = jnp.stack([_centred_mean(ug[:, :, i], w) for i, w in enumerate(POOL_WINDOWS)], axis=2)
    mixed = jnp.einsum('blgc,gcd->blgd', pooled - ug, w_grp).reshape(b_, l_, WIDTH)
    return (mixed * scale * jax.nn.silu(g)) @ w_out


def _dwconv3(y, w, b):
    out = lax.conv_general_dilated(y, w[:, None, :], window_strides=(1,), padding=((1, 1),),
                                   dimension_numbers=('NWC', 'WIO', 'NWC'),
                                   feature_group_count=WIDTH)
    return out + b


def _conv_mixer(h, w_in, conv_w, conv_b, w_out):
    bg, cg, v, g = jnp.split(h @ w_in, 4, axis=-1)
    y = bg * _dwconv3(cg * v, conv_w, conv_b)
    return (y * jax.nn.silu(g)) @ w_out


def _na_mixer(h, hc, w_in, rpb, w_out, need_ctx_out):
    b_, l_, _ = h.shape
    rows = l_ // GRID_W
    wr = min(WIN_ROWS_MAX, rows)
    q, k, v, g = jnp.split(h @ w_in, 4, axis=-1)
    q = q.reshape(b_, rows, GRID_W, N_HEADS, HEAD_DIM) * HEAD_DIM ** -0.5
    k = k.reshape(b_, rows, GRID_W, N_HEADS, HEAD_DIM)
    v = v.reshape(b_, rows, GRID_W, N_HEADS, HEAD_DIM)
    if need_ctx_out:
        qc, kc, vc, gc = jnp.split(hc @ w_in, 4, axis=-1)
    else:
        kc, vc = jnp.split(hc @ w_in[:, WIDTH:3 * WIDTH], 2, axis=-1)
    n_ctx = hc.shape[1]
    kc = kc.reshape(b_, n_ctx, N_HEADS, HEAD_DIM)
    vc = vc.reshape(b_, n_ctx, N_HEADS, HEAD_DIM)

    r = jnp.arange(rows)
    row_idx = jnp.clip(r - wr // 2, 0, rows - wr)[:, None] + jnp.arange(wr)[None, :]
    col = jnp.arange(GRID_W)
    col_idx = jnp.clip(col - WIN_COLS // 2, 0, GRID_W - WIN_COLS)[:, None] + jnp.arange(WIN_COLS)[None, :]
    sel = jax.nn.one_hot(col_idx, GRID_W, dtype=h.dtype)

    kb = k[:, row_idx]
    vb = v[:, row_idx]
    s_blk = jnp.einsum('brqhd,brikhd->bhrqik', q, kb)
    s_loc = jnp.einsum('bhrqik,qjk->bhrqij', s_blk, sel).astype(jnp.float32)
    dr_idx = row_idx - r[:, None] + WIN_ROWS_MAX - 1
    dc_idx = col_idx - col[:, None] + WIN_COLS - 1
    bias = rpb[:, dr_idx[:, None, :, None], dc_idx[None, :, None, :]].astype(jnp.float32)
    s_loc = s_loc + bias[None]
    s_ctx = jnp.einsum('brqhd,bchd->bhrqc', q, kc).astype(jnp.float32)
    n_loc = wr * WIN_COLS
    logits = jnp.concatenate([s_loc.reshape(b_, N_HEADS, rows, GRID_W, n_loc), s_ctx], axis=-1)
    p = jax.nn.softmax(logits, axis=-1).astype(v.dtype)
    p_loc = p[..., :n_loc].reshape(b_, N_HEADS, rows, GRID_W, wr, WIN_COLS)
    p_ctx = p[..., n_loc:]
    p_blk = jnp.einsum('bhrqij,qjk->bhrqik', p_loc, sel)
    o = jnp.einsum('bhrqik,brikhd->brqhd', p_blk, vb) + jnp.einsum('bhrqc,bchd->brqhd', p_ctx, vc)
    y = (o.reshape(b_, l_, WIDTH) * jax.nn.silu(g)) @ w_out

    yc = None
    if need_ctx_out:
        qc = qc.reshape(b_, n_ctx, N_HEADS, HEAD_DIM) * HEAD_DIM ** -0.5
        sc = jnp.einsum('bqhd,bkhd->bhqk', qc, kc).astype(jnp.float32)
        pc = jax.nn.softmax(sc, axis=-1).astype(vc.dtype)
        oc = jnp.einsum('bhqk,bkhd->bqhd', pc, vc).reshape(b_, n_ctx, WIDTH)
        yc = (oc * jax.nn.silu(gc)) @ w_out
    return y, yc


def setup_inputs(seed: int = 0) -> dict:
    key = jax.random.key(seed)
    ks = jax.random.split(key, 20)
    nrm = jax.random.normal
    d, w = D_MODEL, WIDTH
    return {
        "x": nrm(ks[0], (BATCH, SEQ, d), jnp.float32),
        "c": nrm(ks[1], (BATCH, d), jnp.float32),
        "ctx": nrm(ks[2], (BATCH, CTX_LEN, d), jnp.float32),
        "c_ctx": nrm(ks[3], (d,), jnp.float32),
        "norm_g": 1.0 + 0.02 * nrm(ks[4], (DEPTH, d), jnp.float32),
        "ada_w": 0.5 * d ** -0.5 * nrm(ks[5], (DEPTH, d, 3 * d), jnp.float32),
        "ada_b": 0.01 * nrm(ks[6], (DEPTH, 3 * d), jnp.float32),
        "pool_w_in": d ** -0.5 * nrm(ks[7], (N_POOL_LAYERS, d, 2 * w), jnp.float32),
        "pool_w_grp": POOL_GROUP ** -0.5 * nrm(ks[8], (N_POOL_LAYERS, N_POOL_GROUPS, POOL_GROUP, POOL_GROUP), jnp.float32),
        "pool_scale": 1.0 + 0.1 * nrm(ks[9], (N_POOL_LAYERS, w), jnp.float32),
        "pool_w_out": w ** -0.5 * nrm(ks[10], (N_POOL_LAYERS, w, d), jnp.float32),
        "na_w_in": d ** -0.5 * nrm(ks[11], (N_NA_LAYERS, d, 4 * w), jnp.float32),
        "na_rpb": 0.1 * nrm(ks[12], (N_NA_LAYERS, N_HEADS, 2 * WIN_ROWS_MAX - 1, 2 * WIN_COLS - 1), jnp.float32),
        "na_w_out": w ** -0.5 * nrm(ks[13], (N_NA_LAYERS, w, d), jnp.float32),
        "conv_w_in": d ** -0.5 * nrm(ks[14], (N_CONV_LAYERS, d, 4 * w), jnp.float32),
        "conv_dw": CONV_WIDTH ** -0.5 * nrm(ks[15], (N_CONV_LAYERS, CONV_WIDTH, w), jnp.float32),
        "conv_db": 0.01 * nrm(ks[16], (N_CONV_LAYERS, w), jnp.float32),
        "conv_w_out": w ** -0.5 * nrm(ks[17], (N_CONV_LAYERS, w, d), jnp.float32),
        "final_g": 1.0 + 0.02 * nrm(ks[18], (d,), jnp.float32),
    }


def reference(x, c, ctx, c_ctx, norm_g, ada_w, ada_b, pool_w_in, pool_w_grp, pool_scale, pool_w_out,
              na_w_in, na_rpb, na_w_out, conv_w_in, conv_dw, conv_db, conv_w_out, final_g):
    last_ctx_reader = max([i for i in range(DEPTH) if i % N_MIXERS == 1], default=-1)
    for i in range(DEPTH):
        kind, j = i % N_MIXERS, i // N_MIXERS
        update_ctx = i < last_ctx_reader
        shift, scale, gate = _modulation(c, ada_w[i], ada_b[i])
        hx = _rmsnorm(x, norm_g[i]) * (1.0 + scale[:, None]) + shift[:, None]
        if kind == 1 or update_ctx:
            cshift, cscale, cgate = _modulation(c_ctx, ada_w[i], ada_b[i])
            hc = _rmsnorm(ctx, norm_g[i]) * (1.0 + cscale) + cshift
        if kind == 0:
            yx = _pool_mixer(hx, pool_w_in[j], pool_w_grp[j], pool_scale[j], pool_w_out[j])
            if update_ctx:
                yc = _pool_mixer(hc, pool_w_in[j], pool_w_grp[j], pool_scale[j], pool_w_out[j])
        elif kind == 1:
            yx, yc = _na_mixer(hx, hc, na_w_in[j], na_rpb[j], na_w_out[j], update_ctx)
        else:
            yx = _conv_mixer(hx, conv_w_in[j], conv_dw[j], conv_db[j], conv_w_out[j])
            if update_ctx:
                yc = _conv_mixer(hc, conv_w_in[j], conv_dw[j], conv_db[j], conv_w_out[j])
        x = x + gate[:, None] * yx
        if update_ctx:
            ctx = ctx + cgate * yc
    return _rmsnorm(x, final_g)
```

```cpp
#include <hip/hip_runtime.h>
#include <cstdio>
#include <cstdint>

#ifndef MK_PER_PHASE
#define MK_PER_PHASE 0
#endif
#ifndef MK_NAIVE_ATTN
#define MK_NAIVE_ATTN 1
#endif

#define GAS __attribute__((address_space(1)))
#define LAS __attribute__((address_space(3)))
typedef unsigned short bf16_t;
typedef short bf16x8 __attribute__((ext_vector_type(8)));
typedef float f32x4 __attribute__((ext_vector_type(4)));
typedef unsigned u32x4 __attribute__((ext_vector_type(4)));
typedef unsigned u32x2 __attribute__((ext_vector_type(2)));
typedef float f32x2_t __attribute__((ext_vector_type(2)));
typedef __bf16 bf16x2_t __attribute__((ext_vector_type(2)));

constexpr int DM = 1024, NB = 8, SEQ = 2048, CTXL = 256;
constexpr int MX = NB * SEQ;
constexpr int MC = NB * CTXL;
constexpr int MT = MX + MC;
constexpr float EPS = 1e-6f;
constexpr float LOG2E = 1.4426950408889634f;
constexpr float QSCALE = 0.125f * LOG2E;

__device__ __forceinline__ unsigned cvtpk(float lo, float hi) { f32x2_t v = {lo, hi}; bf16x2_t b = __builtin_convertvector(v, bf16x2_t); return __builtin_bit_cast(unsigned, b); }
__device__ __forceinline__ float bflo(unsigned u) { return __builtin_bit_cast(float, u << 16); }
__device__ __forceinline__ float bfhi(unsigned u) { return __builtin_bit_cast(float, u & 0xffff0000u); }
__device__ __forceinline__ float silu_f(float v) { return v * __builtin_amdgcn_rcpf(1.0f + __builtin_amdgcn_exp2f(-LOG2E * v)); }
__device__ __forceinline__ float wave_sum(float v) {
#pragma unroll
    for (int o = 1; o < 64; o <<= 1) v += __shfl_xor(v, o);
    return v;
}
__device__ __forceinline__ float wave_max(float v) {
#pragma unroll
    for (int o = 1; o < 64; o <<= 1) v = fmaxf(v, __shfl_xor(v, o));
    return v;
}

namespace pg8 {
#define PG8_LAS __attribute__((address_space(3)))
constexpr int BM = 256, BK = 64, HALF = 128, HTB = HALF * BK * 2, STAGE_BYTES = 8 * HTB, NXCD = 8, WGM = 8;

__host__ __device__ __forceinline__ int lds_byte(int r, int c) { const int st = (r >> 4) * 2 + (c >> 5), rr = r & 15, cc = c & 31, ob = rr * 64 + cc * 2; return st * 1024 + (ob ^ (((ob >> 9) & 1) << 5)); }
__host__ __device__ __forceinline__ void stage_rc(int b, int& R, int& C) { const int st = b / 1024, sb = b % 1024, swz = sb ^ (((sb >> 9) & 1) << 5); R = (st >> 1) * 16 + swz / 64; C = (st & 1) * 32 + (swz % 64) / 2; }
__host__ __device__ __forceinline__ int perm32(int rho) { const int n = rho >> 4, i = rho & 15; return 8 * (i >> 2) + 4 * n + (i & 3); }

struct Unit { int pm, pn; };
struct Gemm { const bf16_t* A; const bf16_t* Bt; int M, N, K, lda, ldb, acol; };

struct StaticOrder {
    int nM, nN, nwg, G, c;
    __host__ __device__ void init(int M, int N, int G_, int c_) { nM = M / BM; nN = N / BM; nwg = nM * nN; G = G_; c = c_; }
    __host__ __device__ bool next(int i, Unit& u) const {
        const long L = (long)i * G + c; if (L >= nwg) return false;
        int wgid = (int)L; { const int q = nwg / NXCD, r = nwg % NXCD, xcd = wgid % NXCD, off = wgid / NXCD; wgid = (xcd < r ? xcd * (q + 1) : r * (q + 1) + (xcd - r) * q) + off; }
        const int nig = WGM * nN, gid = wgid / nig, fm = gid * WGM, gsz = (nM - fm) < WGM ? (nM - fm) : WGM;
        u.pm = fm + ((wgid % nig) % gsz); u.pn = (wgid % nig) / gsz; return true;
    }
};

template <class Epi, class Sched, bool ALIGN_EPI = true>
__device__ __forceinline__ void gemm_phase(PG8_LAS unsigned char* lds, const Gemm g, const Sched& S, const Epi& E) {
    const int tid = threadIdx.x, wid = __builtin_amdgcn_readfirstlane(tid >> 6), lane = tid & 63, wr = wid >> 2, wc = wid & 3, fr = lane & 15, fq = lane >> 4;
    const int K = g.K, nt = K / BK;
    unsigned voffA[2], voffB[2];
#pragma unroll
    for (int i = 0; i < 2; ++i) { int R, C; stage_rc(tid * 16 + i * 8192, R, C); const int Rb = Epi::PERM ? ((R & ~31) + perm32(R & 31)) : R;
        voffA[i] = (unsigned)(R * g.lda + C) * 2u; voffB[i] = (unsigned)(Rb * g.ldb + C) * 2u; }
    const size_t kstep = (size_t)(BK * 2);
    const size_t hstepA = (size_t)HALF * g.lda * 2, hstepB = (size_t)HALF * g.ldb * 2;
    const size_t tstepA = 2 * hstepA, tstepB = 2 * hstepB;
    const unsigned ldsw = (unsigned)wid * 1024u;
    const int aoff = lds_byte(wr * 64 + fr, fq * 8), boff = lds_byte(wc * 32 + fr, fq * 8);
#define PG8_SA(b, h) (((b) * 2 + (h)) * HTB)
#define PG8_SB(b, h) ((4 + (b) * 2 + (h)) * HTB)
#define PG8_STAGE(bufoff, gbase, voff) do { _Pragma("unroll") for (int _i = 0; _i < 2; ++_i) \
        __builtin_amdgcn_global_load_lds((const unsigned*)((const char*)(gbase) + (voff)[_i]), (PG8_LAS unsigned*)(lds + (bufoff) + ldsw + _i * 8192), 16, 0, 0); } while (0)
#define PG8_LDA(dst, b, h) do { _Pragma("unroll") for (int m = 0; m < 4; ++m) _Pragma("unroll") for (int k = 0; k < 2; ++k) dst[m][k] = *(const PG8_LAS bf16x8*)(lds + PG8_SA(b, h) + aoff + m * 2048 + k * 1024); } while (0)
#define PG8_LDB(dst, b, h) do { _Pragma("unroll") for (int n = 0; n < 2; ++n) _Pragma("unroll") for (int k = 0; k < 2; ++k) dst[n][k] = *(const PG8_LAS bf16x8*)(lds + PG8_SB(b, h) + boff + n * 2048 + k * 1024); } while (0)
#define PG8_MMA(ai, bj, At, Bt) do { __builtin_amdgcn_s_setprio(1); _Pragma("unroll") for (int m = 0; m < 4; ++m) _Pragma("unroll") for (int n = 0; n < 2; ++n) _Pragma("unroll") for (int k = 0; k < 2; ++k) \
        acc[ai][bj][m][n] = __builtin_amdgcn_mfma_f32_16x16x32_bf16(Bt[n][k], At[m][k], acc[ai][bj][m][n], 0, 0, 0); __builtin_amdgcn_s_setprio(0); } while (0)
#define PG8_WAIT_V(n) asm volatile("s_waitcnt vmcnt(" #n ")" ::: "memory")
#define PG8_WAIT_L(n) asm volatile("s_waitcnt lgkmcnt(" #n ")" ::: "memory")
#define PG8_BAR __builtin_amdgcn_s_barrier()
#define PG8_SCHED __builtin_amdgcn_sched_barrier(0)
    Unit cur, nxt; int ui = 0;
    if (!S.next(0, cur)) return;
    f32x4 acc[2][2][4][2];
#pragma unroll
    for (int a = 0; a < 2; ++a)
#pragma unroll
        for (int b = 0; b < 2; ++b)
#pragma unroll
            for (int m = 0; m < 4; ++m)
#pragma unroll
                for (int n = 0; n < 2; ++n) acc[a][b][m][n] = (f32x4){0.f, 0.f, 0.f, 0.f};
    bf16x8 At[4][2], B0[2][2], B1[2][2];
    const char* cA = (const char*)g.A + (size_t)cur.pm * tstepA + (size_t)cur.pn * g.acol * 2; const char* cB = (const char*)g.Bt + (size_t)cur.pn * tstepB;
    PG8_STAGE(PG8_SB(0, 0), cB, voffB); PG8_STAGE(PG8_SB(0, 1), cB + hstepB, voffB); PG8_STAGE(PG8_SA(0, 0), cA, voffA); PG8_STAGE(PG8_SA(0, 1), cA + hstepA, voffA);
    if (wr == 1) PG8_BAR;
    PG8_WAIT_V(2); PG8_BAR;
    PG8_STAGE(PG8_SB(1, 0), cB + kstep, voffB); PG8_STAGE(PG8_SA(1, 0), cA + kstep, voffA); PG8_STAGE(PG8_SB(1, 1), cB + hstepB + kstep, voffB);
    PG8_WAIT_V(6); PG8_BAR;
    for (;;) {
        const bool has_next = S.next(ui + 1, nxt);
        const char* nA = has_next ? (const char*)g.A + (size_t)nxt.pm * tstepA + (size_t)nxt.pn * g.acol * 2 : cA; const char* nB = has_next ? (const char*)g.Bt + (size_t)nxt.pn * tstepB : cB;
        for (int t = 0; t < nt; t += 2) {
            const bool last = (t == nt - 2);
            const char* a1 = cA + (size_t)(t + 1) * kstep;
            const char* a2 = last ? nA : cA + (size_t)(t + 2) * kstep; const char* b2 = last ? nB : cB + (size_t)(t + 2) * kstep;
            const char* a3 = a2 + kstep; const char* b3 = b2 + kstep;
            PG8_LDB(B0, 0, 0); PG8_LDB(B1, 0, 1); PG8_SCHED; PG8_LDA(At, 0, 0); PG8_STAGE(PG8_SA(1, 1), a1 + hstepA, voffA);
            PG8_WAIT_V(8); PG8_WAIT_L(0); PG8_BAR; PG8_MMA(0, 0, At, B0); PG8_MMA(0, 1, At, B1); PG8_BAR; PG8_SCHED;
            PG8_LDA(At, 0, 1); PG8_STAGE(PG8_SB(0, 0), b2, voffB); PG8_STAGE(PG8_SB(0, 1), b2 + hstepB, voffB); PG8_STAGE(PG8_SA(0, 0), a2, voffA);
            PG8_WAIT_V(8); PG8_WAIT_L(0); PG8_BAR; PG8_MMA(1, 0, At, B0); PG8_MMA(1, 1, At, B1); PG8_BAR; PG8_SCHED;
            PG8_LDB(B0, 1, 0); PG8_LDB(B1, 1, 1); PG8_SCHED; PG8_LDA(At, 1, 0); PG8_STAGE(PG8_SA(0, 1), a2 + hstepA, voffA);
            PG8_WAIT_V(8); PG8_WAIT_L(0); PG8_BAR; PG8_MMA(0, 0, At, B0); PG8_MMA(0, 1, At, B1); PG8_BAR; PG8_SCHED;
            PG8_LDA(At, 1, 1); PG8_STAGE(PG8_SB(1, 0), b3, voffB); PG8_STAGE(PG8_SB(1, 1), b3 + hstepB, voffB); PG8_STAGE(PG8_SA(1, 0), a3, voffA);
            PG8_WAIT_V(8); PG8_WAIT_L(0); PG8_BAR; PG8_MMA(1, 0, At, B0); PG8_MMA(1, 1, At, B1); PG8_BAR; PG8_SCHED;
        }
        if constexpr (ALIGN_EPI) { if (wr == 0) PG8_BAR; }
        E(acc, cur, wr, wc, fr, fq);
        if (!has_next) break;
#pragma unroll
        for (int a = 0; a < 2; ++a)
#pragma unroll
            for (int b = 0; b < 2; ++b)
#pragma unroll
                for (int m = 0; m < 4; ++m)
#pragma unroll
                    for (int n = 0; n < 2; ++n) acc[a][b][m][n] = (f32x4){0.f, 0.f, 0.f, 0.f};
        cur = nxt; cA = nA; cB = nB; ++ui;
        if constexpr (ALIGN_EPI) { if (wr == 1) PG8_BAR; }
    }
    PG8_WAIT_V(0);
    if constexpr (!ALIGN_EPI) { if (wr == 0) PG8_BAR; }
    PG8_BAR;
#undef PG8_SA
#undef PG8_SB
#undef PG8_STAGE
#undef PG8_LDA
#undef PG8_LDB
#undef PG8_MMA
#undef PG8_WAIT_V
#undef PG8_WAIT_L
#undef PG8_BAR
#undef PG8_SCHED
}

__device__ __forceinline__ float row_rstd(const float* ssq, int row) {
    const f32x4* p = (const f32x4*)(ssq + (size_t)row * 16);
    const f32x4 a = p[0], b = p[1], c = p[2], d = p[3];
    const float s = ((a.x + a.y) + (a.z + a.w)) + ((b.x + b.y) + (b.z + b.w)) + ((c.x + c.y) + (c.z + c.w)) + ((d.x + d.y) + (d.z + d.w));
    return rsqrtf(s * (1.0f / 1024.0f) + EPS);
}
__device__ __forceinline__ u32x4 pack8(const f32x4 v0, const f32x4 v1) { u32x4 w; w.x = cvtpk(v0[0], v0[1]); w.y = cvtpk(v0[2], v0[3]); w.z = cvtpk(v1[0], v1[1]); w.w = cvtpk(v1[2], v1[3]); return w; }

struct EpiPool1 {
    static constexpr bool PERM = true;
    const float* ssq; const float* cvec; const float* pscale; bf16_t* U; bf16_t* SG;
    __device__ __forceinline__ void operator()(const f32x4 (&acc)[2][2][4][2], const Unit& u, int wr, int wc, int fr, int fq) const {
        const int bm = u.pm < 64 ? (u.pm >> 3) : 8;
        const bool isg = u.pn >= 4;
        const int ct = u.pn * 256 + wc * 32 + 8 * fq, co = (u.pn & 3) * 256 + wc * 32 + 8 * fq;
        f32x4 cv[2][2], sc[2][2];
#pragma unroll
        for (int bj = 0; bj < 2; ++bj)
#pragma unroll
            for (int n = 0; n < 2; ++n) { cv[bj][n] = *(const f32x4*)(cvec + (size_t)bm * 4096 + ct + bj * 128 + 4 * n);
                sc[bj][n] = isg ? *(const f32x4*)(pscale + co + bj * 128 + 4 * n) : (f32x4){1.f, 1.f, 1.f, 1.f}; }
        bf16_t* O = isg ? SG : U;
#pragma unroll
        for (int ai = 0; ai < 2; ++ai)
#pragma unroll
            for (int m = 0; m < 4; ++m) { const int row = u.pm * 256 + ai * 128 + wr * 64 + m * 16 + fr; const float rs = row_rstd(ssq, row);
#pragma unroll
                for (int bj = 0; bj < 2; ++bj) { f32x4 v0 = acc[ai][bj][m][0] * rs + cv[bj][0], v1 = acc[ai][bj][m][1] * rs + cv[bj][1];
                    if (isg) {
#pragma unroll
                        for (int j = 0; j < 4; ++j) { v0[j] = sc[bj][0][j] * silu_f(v0[j]); v1[j] = sc[bj][1][j] * silu_f(v1[j]); } }
                    *(u32x4*)(O + (size_t)row * 1024 + co + bj * 128) = pack8(v0, v1); }
                if (m & 1) asm volatile("" ::: "memory"); }
    }
};
struct EpiPool2 {
    static constexpr bool PERM = true;
    const bf16_t* SG; bf16_t* Z;
    __device__ __forceinline__ void operator()(const f32x4 (&acc)[2][2][4][2], const Unit& u, int wr, int wc, int fr, int fq) const {
        const int co = u.pn * 256 + wc * 32 + 8 * fq;
#pragma unroll
        for (int ai = 0; ai < 2; ++ai)
#pragma unroll
            for (int m = 0; m < 4; ++m) { const int row = u.pm * 256 + ai * 128 + wr * 64 + m * 16 + fr;
#pragma unroll
                for (int bj = 0; bj < 2; ++bj) { const u32x4 s = *(const u32x4*)(SG + (size_t)row * 1024 + co + bj * 128);
                    f32x4 v0 = acc[ai][bj][m][0], v1 = acc[ai][bj][m][1];
                    v0[0] *= bflo(s.x); v0[1] *= bfhi(s.x); v0[2] *= bflo(s.y); v0[3] *= bfhi(s.y);
                    v1[0] *= bflo(s.z); v1[1] *= bfhi(s.z); v1[2] *= bflo(s.w); v1[3] *= bfhi(s.w);
                    *(u32x4*)(Z + (size_t)row * 1024 + co + bj * 128) = pack8(v0, v1); }
                if (m & 1) asm volatile("" ::: "memory"); }
    }
};
struct EpiNa1 {
    static constexpr bool PERM = true;
    const float* ssq; const float* cvec; bf16_t* out; size_t tstride; int tbase; int bmfix;
    __device__ __forceinline__ void operator()(const f32x4 (&acc)[2][2][4][2], const Unit& u, int wr, int wc, int fr, int fq) const {
        const int bm = bmfix >= 0 ? bmfix : (u.pm >> 3);
        const int t = tbase + (u.pn >> 2);
        const int ct = u.pn * 256 + wc * 32 + 8 * fq, co = (u.pn & 3) * 256 + wc * 32 + 8 * fq;
        f32x4 cv[2][2];
#pragma unroll
        for (int bj = 0; bj < 2; ++bj)
#pragma unroll
            for (int n = 0; n < 2; ++n) cv[bj][n] = *(const f32x4*)(cvec + (size_t)bm * 4096 + ct + bj * 128 + 4 * n);
        bf16_t* O = out + (size_t)t * tstride;
#pragma unroll
        for (int ai = 0; ai < 2; ++ai)
#pragma unroll
            for (int m = 0; m < 4; ++m) { const int row = u.pm * 256 + ai * 128 + wr * 64 + m * 16 + fr; const float rs = row_rstd(ssq, row);
#pragma unroll
                for (int bj = 0; bj < 2; ++bj) { f32x4 v0 = acc[ai][bj][m][0] * rs + cv[bj][0], v1 = acc[ai][bj][m][1] * rs + cv[bj][1];
                    if (t == 0) { v0 = v0 * QSCALE; v1 = v1 * QSCALE; }
                    if (t == 3) {
#pragma unroll
                        for (int j = 0; j < 4; ++j) { v0[j] = silu_f(v0[j]); v1[j] = silu_f(v1[j]); } }
                    *(u32x4*)(O + (size_t)row * 1024 + co + bj * 128) = pack8(v0, v1); }
                if (m & 1) asm volatile("" ::: "memory"); }
    }
};
struct EpiConv1 {
    static constexpr bool PERM = true;
    const float* ssq; const float* cvec; bf16_t* P; bf16_t* S;
    __device__ __forceinline__ void operator()(const f32x4 (&acc)[2][2][4][2], const Unit& u, int wr, int wc, int fr, int fq) const {
        const int bm = u.pm >> 3;
        const int ct = u.pn * 256 + wc * 32 + 8 * fq, ch0 = u.pn * 64 + wc * 16 + 4 * fq;
        f32x4 cv[2][2];
#pragma unroll
        for (int bj = 0; bj < 2; ++bj)
#pragma unroll
            for (int n = 0; n < 2; ++n) cv[bj][n] = *(const f32x4*)(cvec + (size_t)bm * 4096 + ct + bj * 128 + 4 * n);
#pragma unroll
        for (int ai = 0; ai < 2; ++ai)
#pragma unroll
            for (int m = 0; m < 4; ++m) { const int row = u.pm * 256 + ai * 128 + wr * 64 + m * 16 + fr; const float rs = row_rstd(ssq, row);
                const f32x4 bg = acc[ai][0][m][0] * rs + cv[0][0], cg = acc[ai][0][m][1] * rs + cv[0][1], vv = acc[ai][1][m][0] * rs + cv[1][0], gg = acc[ai][1][m][1] * rs + cv[1][1];
                f32x4 p = cg * vv, s;
#pragma unroll
                for (int j = 0; j < 4; ++j) s[j] = bg[j] * silu_f(gg[j]);
                u32x2 pw, sw; pw.x = cvtpk(p[0], p[1]); pw.y = cvtpk(p[2], p[3]); sw.x = cvtpk(s[0], s[1]); sw.y = cvtpk(s[2], s[3]);
                *(u32x2*)(P + (size_t)row * 1024 + ch0) = pw; *(u32x2*)(S + (size_t)row * 1024 + ch0) = sw;
                if (m & 1) asm volatile("" ::: "memory"); }
    }
};
struct EpiOut {
    static constexpr bool PERM = false;
    const float* basex; const float* basec; float* outx; float* outc;
    const float* gate;
    const float* gnext;
    const float* scnext;
    bf16_t* XT; float* ssq;
    __device__ __forceinline__ void operator()(const f32x4 (&acc)[2][2][4][2], const Unit& u, int wr, int wc, int fr, int fq) const {
        const bool isc = u.pm >= 64; const int bm = isc ? 8 : (u.pm >> 3);
        const int col0 = u.pn * 256 + wc * 32 + 4 * fq;
        f32x4 gt[2][2], an[2][2];
#pragma unroll
        for (int bj = 0; bj < 2; ++bj)
#pragma unroll
            for (int n = 0; n < 2; ++n) { gt[bj][n] = *(const f32x4*)(gate + (size_t)bm * 3072 + col0 + bj * 128 + n * 16);
                if (gnext) an[bj][n] = *(const f32x4*)(gnext + col0 + bj * 128 + n * 16) * (*(const f32x4*)(scnext + (size_t)bm * 3072 + col0 + bj * 128 + n * 16) + 1.0f);
                else an[bj][n] = (f32x4){0.f, 0.f, 0.f, 0.f}; }
        const float* bp = isc ? basec - (size_t)MX * 1024 : basex; float* op = isc ? outc - (size_t)MX * 1024 : outx;
#pragma unroll
        for (int ai = 0; ai < 2; ++ai)
#pragma unroll
            for (int m = 0; m < 4; ++m) { const int row = u.pm * 256 + ai * 128 + wr * 64 + m * 16 + fr; const size_t off = (size_t)row * 1024 + col0; float s = 0.f;
#pragma unroll
                for (int bj = 0; bj < 2; ++bj)
#pragma unroll
                    for (int n = 0; n < 2; ++n) { const f32x4 x = *(const f32x4*)(bp + off + bj * 128 + n * 16); const f32x4 y = x + gt[bj][n] * acc[ai][bj][m][n];
                        *(f32x4*)(op + off + bj * 128 + n * 16) = y; s += (y[0] * y[0] + y[1] * y[1]) + (y[2] * y[2] + y[3] * y[3]);
                        if (gnext) { const f32x4 tt = y * an[bj][n]; u32x2 w; w.x = cvtpk(tt[0], tt[1]); w.y = cvtpk(tt[2], tt[3]); *(u32x2*)(XT + off + bj * 128 + n * 16) = w; } }
                s += __shfl_xor(s, 16); s += __shfl_xor(s, 32);
                if (fq == 0) ssq[(size_t)row * 16 + u.pn * 4 + wc] = s;
                asm volatile("" ::: "memory"); }
    }
};
}

constexpr size_t MiB = 1u << 20;
constexpr size_t WS_CTL = 0, CTL_ZERO_BYTES = 1 * MiB;
constexpr size_t WS_MOD = 1 * MiB;
constexpr size_t WS_CVEC = 2 * MiB;
constexpr size_t WS_SSQ = 3 * MiB;
constexpr size_t WS_WPIN = 6 * MiB;
constexpr size_t WS_WGRP = 14 * MiB;
constexpr size_t WS_WPOUT = 15 * MiB;
constexpr size_t WS_WNIN = 19 * MiB;
constexpr size_t WS_WNOUT = 27 * MiB;
constexpr size_t WS_WCIN = 29 * MiB;
constexpr size_t WS_WCOUT = 37 * MiB;
constexpr size_t WS_XC = 40 * MiB;
constexpr size_t WS_XT = 48 * MiB;
constexpr size_t WS_ACT0 = 84 * MiB, ACT_STRIDE = 36 * MiB;
constexpr size_t WS_END = 228 * MiB;
constexpr int CW_BAR = 4096;

#define XB_TMO      128
#define XB_XCNT(j)  (256  + 64 * (j))
#define XB_XSUB(j)  (1280 + 64 * (j))
#define XB_XGEN(j)  (2304 + 64 * (j))
#define XB_TOP      3328
#define XB_TOPGEN   3392
#define XCD_BAR_WORDS 3456
#define XB_SPIN_CAP (1u << 18)
__device__ __forceinline__ unsigned xb_ld(unsigned* p)              { return __hip_atomic_load(p, __ATOMIC_RELAXED, __HIP_MEMORY_SCOPE_AGENT); }
__device__ __forceinline__ unsigned xb_add(unsigned* p, unsigned v) { return __hip_atomic_fetch_add(p, v, __ATOMIC_RELAXED, __HIP_MEMORY_SCOPE_AGENT); }
__device__ __forceinline__ unsigned xb_xcc_id() { return (unsigned)__builtin_amdgcn_s_getreg((3 << 11) | 20) & 0xFu; }
#define XB_SPIN(cond, bar) do { unsigned _sp = 0; while (cond) { __builtin_amdgcn_s_sleep(1); \
    if ((++_sp & 255u) == 0u) { if (xb_ld(&(bar)[XB_TMO])) break; if (_sp > XB_SPIN_CAP) { atomicAdd(&(bar)[XB_TMO], 1u); break; } } } } while (0)
struct XcdBarrier { unsigned* bar; unsigned x; volatile LAS unsigned* st; };
__device__ __forceinline__ XcdBarrier xcd_barrier_post(unsigned* bar, volatile LAS unsigned* st) {
    XcdBarrier b; b.bar = bar; b.x = xb_xcc_id(); b.st = st;
    if (threadIdx.x == 0) (void)xb_add(&bar[XB_XCNT(b.x)], 1u);
    return b;
}
__device__ __forceinline__ void xcd_barrier_complete(unsigned* bar, unsigned x, unsigned& nloc, unsigned& nx) {
    const unsigned G = gridDim.x * gridDim.y * gridDim.z;
    unsigned sum, cnt, mine, sp = 0u;
    for (;;) {
        sum = 0u; cnt = 0u; mine = 0u;
#pragma unroll
        for (unsigned j = 0; j < 16; ++j) { const unsigned c = xb_ld(&bar[XB_XCNT(j)]); sum += c; cnt += (c > 0u) ? 1u : 0u; mine = (j == x) ? c : mine; }
        if (sum == G) break;
        __builtin_amdgcn_s_sleep(1);
        if ((++sp & 255u) == 0u) { if (xb_ld(&bar[XB_TMO])) break; if (sp > XB_SPIN_CAP) { atomicAdd(&bar[XB_TMO], 1u); break; } }
    }
    nloc = mine > 0u ? mine : 1u; nx = cnt > 0u ? cnt : 1u;
}
__device__ __forceinline__ void xcd_barrier(const XcdBarrier& b) {
    asm volatile("s_waitcnt vmcnt(0)" ::: "memory");
    __syncthreads();
    if (threadIdx.x == 0) {
        unsigned* bar = b.bar;
        __builtin_amdgcn_s_waitcnt(0);
        unsigned nloc = b.st[0], nx = b.st[1];
        if (nloc == 0u) { xcd_barrier_complete(bar, b.x, nloc, nx); b.st[0] = nloc; b.st[1] = nx; }
        const unsigned old = xb_add(&bar[XB_XSUB(b.x)], 1u);
        const unsigned gen = old / nloc;
        if (old + 1u == (gen + 1u) * nloc) {
            __builtin_amdgcn_fence(__ATOMIC_RELEASE, "agent");
            asm volatile("s_waitcnt vmcnt(0)" ::: "memory");
            const unsigned og = xb_add(&bar[XB_TOP], 1u);
            const unsigned tg = og / nx;
            if (og + 1u == (tg + 1u) * nx) xb_add(&bar[XB_TOPGEN], 1u);
            else XB_SPIN(xb_ld(&bar[XB_TOPGEN]) == tg, bar);
            __builtin_amdgcn_fence(__ATOMIC_ACQUIRE, "agent");
            xb_add(&bar[XB_XGEN(b.x)], 1u);
            asm volatile("s_waitcnt vmcnt(0)" ::: "memory");
        } else {
            XB_SPIN(xb_ld(&bar[XB_XGEN(b.x)]) == gen, bar);
            __builtin_amdgcn_fence(__ATOMIC_ACQUIRE, "agent");
            asm volatile("s_waitcnt vmcnt(0)" ::: "memory");
        }
    }
    __syncthreads();
}

constexpr int NWAVES = 8;
constexpr int RING_BYTES = 131072, LDSCTL_OFF = RING_BYTES, MISC_OFF = LDSCTL_OFF + 320, LDS_BYTES = 147456;

struct Args { const float* in[19]; float* out; unsigned char* ws; int ph_lo, ph_hi; };

struct Frame {
    LAS unsigned char* lds; volatile LAS unsigned* MISC;
    int tid, lane, wave, vcu, G;
    const float *x, *c, *ctx, *c_ctx, *norm_g, *ada_w, *ada_b, *pool_w_in, *pool_w_grp, *pool_scale, *pool_w_out, *na_w_in, *na_rpb, *na_w_out, *conv_w_in, *conv_dw, *conv_db, *conv_w_out, *final_g;
    float* out; unsigned char* ws;
    float *MOD, *CVEC, *SSQ, *XC;
    bf16_t *WPIN, *WGRP, *WPOUT, *WNIN, *WNOUT, *WCIN, *WCOUT, *XT, *ACT0;
};

__device__ __forceinline__ void p0_mod_task(Frame& F, int task) {
    const int layer = task / 48, col0 = (task % 48) * 64;
    LAS float* sc = (LAS float*)F.lds;
    LAS float* red = sc + 9 * 1024;
    for (int i = F.tid; i < 9 * 1024; i += NWAVES * 64) { const int b = i >> 10, k = i & 1023; const float v = (b < 8) ? F.c[b * 1024 + k] : F.c_ctx[k]; sc[i] = silu_f(v); }
    __syncthreads();
    const float* W = F.ada_w + (size_t)layer * 1024 * 3072 + col0;
    const int kr = F.lane >> 4, cl = (F.lane & 15) * 4;
    float acc[9][4];
#pragma unroll
    for (int b = 0; b < 9; ++b)
#pragma unroll
        for (int j = 0; j < 4; ++j) acc[b][j] = 0.f;
    const int kbase = F.wave * 128;
#pragma unroll 4
    for (int it = 0; it < 32; ++it) { const int k = kbase + it * 4 + kr; const f32x4 w = *(const f32x4*)(W + (size_t)k * 3072 + cl);
#pragma unroll
        for (int b = 0; b < 9; ++b) { const float s = sc[b * 1024 + k];
#pragma unroll
            for (int j = 0; j < 4; ++j) acc[b][j] += s * w[j]; } }
#pragma unroll
    for (int b = 0; b < 9; ++b)
#pragma unroll
        for (int j = 0; j < 4; ++j) { float v = acc[b][j]; v += __shfl_xor(v, 16); v += __shfl_xor(v, 32); acc[b][j] = v; }
    if (kr == 0) {
#pragma unroll
        for (int b = 0; b < 9; ++b)
#pragma unroll
            for (int j = 0; j < 4; ++j) red[(F.wave * 9 + b) * 64 + cl + j] = acc[b][j]; }
    __syncthreads();
    for (int o = F.tid; o < 576; o += NWAVES * 64) { const int b = o >> 6, cc = o & 63; float s = 0.f;
#pragma unroll
        for (int w = 0; w < 8; ++w) s += red[(w * 9 + b) * 64 + cc];
        F.MOD[(size_t)(layer * 9 + b) * 3072 + col0 + cc] = s + F.ada_b[layer * 3072 + col0 + cc]; }
    __syncthreads();
}
__device__ __forceinline__ unsigned f2bf(float f) { unsigned u = __builtin_bit_cast(unsigned, f); return (u + 0x7fffu + ((u >> 16) & 1u)) >> 16; }
__device__ __forceinline__ unsigned pk2(float lo, float hi) { return f2bf(lo) | (f2bf(hi) << 16); }
__device__ __forceinline__ int conv_row(int n) { const int split = n >> 10, ch = n & 1023; return (ch >> 6) * 256 + (split >> 1) * 128 + ((ch >> 4) & 3) * 32 + ((ch >> 2) & 3) * 8 + (split & 1) * 4 + (ch & 3); }
template <int MODE>
__device__ __forceinline__ void p0_transpose_item(const float* W, int K, int N, bf16_t* WT, LAS float* scr, int item, int lane) {
    const int nblk = N / 32, kb = item / nblk, nb = item % nblk, k0 = 64 * kb, n0 = 32 * nb;
#pragma unroll 8
    for (int i = 0; i < 32; ++i) { const int kk = 2 * i + (lane >> 5); scr[kk * 33 + (lane & 31)] = W[(size_t)(k0 + kk) * N + n0 + (lane & 31)]; }
    asm volatile("s_waitcnt lgkmcnt(0)" ::: "memory");
    const int c = lane & 7;
#pragma unroll
    for (int j = 0; j < 4; ++j) { const int n = (lane >> 3) + 8 * j; const LAS float* s = scr + (8 * c) * 33 + n;
        u32x4 o; o.x = pk2(s[0 * 33], s[1 * 33]); o.y = pk2(s[2 * 33], s[3 * 33]); o.z = pk2(s[4 * 33], s[5 * 33]); o.w = pk2(s[6 * 33], s[7 * 33]);
        const int drow = MODE == 1 ? conv_row(n0 + n) : (n0 + n);
        *(u32x4*)(WT + (size_t)drow * K + k0 + 8 * c) = o; }
    asm volatile("s_waitcnt lgkmcnt(0)" ::: "memory");
}
__device__ __forceinline__ void p0_prologue(Frame& F) {
    for (int t = (int)blockIdx.x; t < 192; t += F.G) p0_mod_task(F, t);
    LAS float* scr = (LAS float*)(F.lds + F.wave * 16384);
    const int gw = F.vcu * NWAVES + F.wave, NGW = F.G * NWAVES;
    constexpr int I_PIN = 16 * 64, I_GRP = 4 * 8, I_SQ = 16 * 32, I_BIG = 16 * 128;
    constexpr int NITEMS = 2 * I_PIN + 8 * I_GRP + 2 * I_SQ + I_BIG + I_SQ + I_BIG + I_SQ;
    for (int it = gw; it < NITEMS; it += NGW) {
        int r = it;
        if (r < 2 * I_PIN) { const int j = r / I_PIN; p0_transpose_item<0>(F.pool_w_in + (size_t)j * 1024 * 2048, 1024, 2048, F.WPIN + (size_t)j * 2048 * 1024, scr, r % I_PIN, F.lane); continue; } r -= 2 * I_PIN;
        if (r < 8 * I_GRP) { const int j = r / I_GRP; p0_transpose_item<0>(F.pool_w_grp + (size_t)j * 65536, 256, 256, F.WGRP + (size_t)j * 65536, scr, r % I_GRP, F.lane); continue; } r -= 8 * I_GRP;
        if (r < 2 * I_SQ) { const int j = r / I_SQ; p0_transpose_item<0>(F.pool_w_out + (size_t)j * 1024 * 1024, 1024, 1024, F.WPOUT + (size_t)j * 1024 * 1024, scr, r % I_SQ, F.lane); continue; } r -= 2 * I_SQ;
        if (r < I_BIG) { p0_transpose_item<0>(F.na_w_in, 1024, 4096, F.WNIN, scr, r, F.lane); continue; } r -= I_BIG;
        if (r < I_SQ) { p0_transpose_item<0>(F.na_w_out, 1024, 1024, F.WNOUT, scr, r, F.lane); continue; } r -= I_SQ;
        if (r < I_BIG) { p0_transpose_item<1>(F.conv_w_in, 1024, 4096, F.WCIN, scr, r, F.lane); continue; } r -= I_BIG;
        p0_transpose_item<0>(F.conv_w_out, 1024, 1024, F.WCOUT, scr, r, F.lane);
    }
}
__device__ __forceinline__ void p1_prep(Frame& F) {
    const int gw = F.vcu * NWAVES + F.wave, NGW = F.G * NWAVES, lane = F.lane;
    for (int task = gw; task < 12288; task += NGW) {
        int L, n; const bf16_t* WT;
        if (task < 2048) { L = 0; n = task; WT = F.WPIN; } else if (task < 6144) { L = 1; n = task - 2048; WT = F.WNIN; } else if (task < 10240) { L = 2; n = task - 6144; WT = F.WCIN; } else { L = 3; n = task - 10240; WT = F.WPIN + (size_t)2048 * 1024; }
        const u32x4 w0 = *(const u32x4*)(WT + (size_t)n * 1024 + lane * 8), w1 = *(const u32x4*)(WT + (size_t)n * 1024 + 512 + lane * 8);
        float wf[16] = {bflo(w0.x), bfhi(w0.x), bflo(w0.y), bfhi(w0.y), bflo(w0.z), bfhi(w0.z), bflo(w0.w), bfhi(w0.w), bflo(w1.x), bfhi(w1.x), bflo(w1.y), bfhi(w1.y), bflo(w1.z), bfhi(w1.z), bflo(w1.w), bfhi(w1.w)};
        const int nb = (L <= 1) ? 9 : 8;
        for (int b = 0; b < nb; ++b) { const float* sh = F.MOD + (size_t)(L * 9 + b) * 3072;
            const f32x4 s0 = *(const f32x4*)(sh + lane * 8), s1 = *(const f32x4*)(sh + lane * 8 + 4), s2 = *(const f32x4*)(sh + 512 + lane * 8), s3 = *(const f32x4*)(sh + 512 + lane * 8 + 4);
            float d = 0.f;
#pragma unroll
            for (int j = 0; j < 4; ++j) d += s0[j] * wf[j] + s1[j] * wf[4 + j] + s2[j] * wf[8 + j] + s3[j] * wf[12 + j];
            d = wave_sum(d);
            if (lane == 0) F.CVEC[(size_t)(L * 9 + b) * 4096 + n] = d; }
    }
    for (int row = gw; row < MT; row += NGW) {
        const float* src = row < MX ? F.x + (size_t)row * 1024 : F.ctx + (size_t)(row - MX) * 1024; const int bm = row < MX ? (row >> 11) : 8;
        const float* scl = F.MOD + (size_t)bm * 3072 + 1024;
        f32x4 v[4]; float ss = 0.f;
#pragma unroll
        for (int j = 0; j < 4; ++j) { v[j] = *(const f32x4*)(src + 256 * j + 4 * lane); ss += (v[j].x * v[j].x + v[j].y * v[j].y) + (v[j].z * v[j].z + v[j].w * v[j].w); }
        ss = wave_sum(ss);
        if (lane < 16) F.SSQ[(size_t)row * 16 + lane] = lane == 0 ? ss : 0.f;
#pragma unroll
        for (int j = 0; j < 4; ++j) { const f32x4 a = *(const f32x4*)(F.norm_g + 256 * j + 4 * lane) * (*(const f32x4*)(scl + 256 * j + 4 * lane) + 1.0f); const f32x4 t = v[j] * a;
            u32x2 w; w.x = cvtpk(t[0], t[1]); w.y = cvtpk(t[2], t[3]); *(u32x2*)(F.XT + (size_t)row * 1024 + 256 * j + 4 * lane) = w; }
    }
}
__device__ __forceinline__ void unpack8(const u32x4 w, float (&f)[8]) { f[0] = bflo(w.x); f[1] = bfhi(w.x); f[2] = bflo(w.y); f[3] = bfhi(w.y); f[4] = bflo(w.z); f[5] = bfhi(w.z); f[6] = bflo(w.w); f[7] = bfhi(w.w); }
__device__ __forceinline__ void e_pool(Frame& F, const bf16_t* U, bf16_t* A2, int nrows) {
    const int gt = F.vcu * (NWAVES * 64) + F.tid, NT = F.G * NWAVES * 64;
    const int nitems = (nrows / 16) * 128;
    for (int id = gt; id < nitems; id += NT) {
        const int col = (id & 127) * 8, r0 = (id >> 7) * 16;
        const int hw = 1 << (col >> 8);
        const int seq0 = r0 < MX ? (r0 & ~(SEQ - 1)) : MX + ((r0 - MX) & ~(CTXL - 1)); const int L = r0 < MX ? SEQ : CTXL;
        const int t0 = r0 - seq0;
        const bf16_t* base = U + (size_t)seq0 * 1024 + col;
        float S[8];
#pragma unroll
        for (int j = 0; j < 8; ++j) S[j] = 0.f;
        { const int lo = max(t0 - hw, 0), hi = min(t0 + hw, L);
          for (int t = lo; t < hi; ++t) { float f[8]; unpack8(*(const u32x4*)(base + (size_t)t * 1024), f);
#pragma unroll
              for (int j = 0; j < 8; ++j) S[j] += f[j]; } }
        for (int i = 0; i < 16; ++i) { const int t = t0 + i; const int lo = max(t - hw, 0), hi = min(t + hw, L); const float inv = 1.0f / (float)(hi - lo);
            float f[8]; unpack8(*(const u32x4*)(base + (size_t)t * 1024), f);
            f32x4 o0, o1;
#pragma unroll
            for (int j = 0; j < 4; ++j) { o0[j] = S[j] * inv - f[j]; o1[j] = S[4 + j] * inv - f[4 + j]; }
            *(u32x4*)(A2 + (size_t)(seq0 + t) * 1024 + col) = pg8::pack8(o0, o1);
            if (t + hw < L) { float a[8]; unpack8(*(const u32x4*)(base + (size_t)(t + hw) * 1024), a);
#pragma unroll
                for (int j = 0; j < 8; ++j) S[j] += a[j]; }
            if (t - hw >= 0) { float a[8]; unpack8(*(const u32x4*)(base + (size_t)(t - hw) * 1024), a);
#pragma unroll
                for (int j = 0; j < 8; ++j) S[j] -= a[j]; } }
    }
}
__device__ __forceinline__ void e_conv(Frame& F, const bf16_t* P, const bf16_t* Sg, bf16_t* Z) {
    const int gt = F.vcu * (NWAVES * 64) + F.tid, NT = F.G * NWAVES * 64;
    const int nitems = (MX / 16) * 128;
    for (int id = gt; id < nitems; id += NT) {
        const int col = (id & 127) * 8, r0 = (id >> 7) * 16, t0 = r0 & (SEQ - 1);
        float w0[8], w1[8], w2[8], bb[8];
#pragma unroll
        for (int h = 0; h < 2; ++h) { const f32x4 a = *(const f32x4*)(F.conv_dw + col + 4 * h), b = *(const f32x4*)(F.conv_dw + 1024 + col + 4 * h), c = *(const f32x4*)(F.conv_dw + 2048 + col + 4 * h), d = *(const f32x4*)(F.conv_db + col + 4 * h);
#pragma unroll
            for (int j = 0; j < 4; ++j) { w0[4 * h + j] = a[j]; w1[4 * h + j] = b[j]; w2[4 * h + j] = c[j]; bb[4 * h + j] = d[j]; } }
        float prev[8], cur[8], nxt[8];
        if (t0 > 0) unpack8(*(const u32x4*)(P + (size_t)(r0 - 1) * 1024 + col), prev); else {
#pragma unroll
            for (int j = 0; j < 8; ++j) prev[j] = 0.f; }
        unpack8(*(const u32x4*)(P + (size_t)r0 * 1024 + col), cur);
        for (int i = 0; i < 16; ++i) { const int t = t0 + i;
            if (t + 1 < SEQ) unpack8(*(const u32x4*)(P + (size_t)(r0 + i + 1) * 1024 + col), nxt); else {
#pragma unroll
                for (int j = 0; j < 8; ++j) nxt[j] = 0.f; }
            float s[8]; unpack8(*(const u32x4*)(Sg + (size_t)(r0 + i) * 1024 + col), s);
            f32x4 o0, o1;
#pragma unroll
            for (int j = 0; j < 4; ++j) { o0[j] = s[j] * (w0[j] * prev[j] + w1[j] * cur[j] + w2[j] * nxt[j] + bb[j]); o1[j] = s[4 + j] * (w0[4 + j] * prev[4 + j] + w1[4 + j] * cur[4 + j] + w2[4 + j] * nxt[4 + j] + bb[4 + j]); }
            *(u32x4*)(Z + (size_t)(r0 + i) * 1024 + col) = pg8::pack8(o0, o1);
#pragma unroll
            for (int j = 0; j < 8; ++j) { prev[j] = cur[j]; cur[j] = nxt[j]; } }
    }
}
__device__ __forceinline__ void e_final(Frame& F) {
    const int gw = F.vcu * NWAVES + F.wave, NGW = F.G * NWAVES, lane = F.lane;
    for (int row = gw; row < MX; row += NGW) {
        const float rs = pg8::row_rstd(F.SSQ, row);
#pragma unroll
        for (int j = 0; j < 4; ++j) { float* p = F.out + (size_t)row * 1024 + 256 * j + 4 * lane; const f32x4 v = *(const f32x4*)p; const f32x4 g = *(const f32x4*)(F.final_g + 256 * j + 4 * lane); *(f32x4*)p = v * rs * g; }
    }
}
__device__ __forceinline__ void attn_naive(Frame& F, const bf16_t* Q, const bf16_t* Kb, const bf16_t* Vb, const bf16_t* SGb, bf16_t* Z) {
    const int gw = F.vcu * NWAVES + F.wave, NGW = F.G * NWAVES, lane = F.lane;
    for (int task = gw; task < MX * 16; task += NGW) {
        const int tok = task >> 4, h = task & 15;
        const int b = tok >> 11, pos = tok & 2047, r = pos >> 6, col = pos & 63;
        const int rs = min(max(r - 4, 0), 24), cs = min(max(col - 8, 0), 48);
        const bf16_t* qp = Q + (size_t)tok * 1024 + h * 64;
        float s[6]; int kt[6];
#pragma unroll
        for (int t = 0; t < 6; ++t) {
            float bias = 0.f; int ktok;
            if (t < 2) { const int kk = lane + 64 * t, i = kk >> 4, jj = kk & 15; ktok = b * 2048 + (rs + i) * 64 + cs + jj;
                bias = F.na_rpb[(h * 15 + (rs + i - r + 7)) * 31 + (cs + jj - col + 15)] * LOG2E; }
            else { ktok = MX + b * 256 + lane + 64 * (t - 2); }
            kt[t] = ktok;
            const bf16_t* kp = Kb + (size_t)ktok * 1024 + h * 64; float d = 0.f;
#pragma unroll
            for (int d8 = 0; d8 < 8; ++d8) { float qf[8], kf[8]; unpack8(*(const u32x4*)(qp + d8 * 8), qf); unpack8(*(const u32x4*)(kp + d8 * 8), kf);
#pragma unroll
                for (int j = 0; j < 8; ++j) d += qf[j] * kf[j]; }
            s[t] = d + bias;
        }
        float m = s[0];
#pragma unroll
        for (int t = 1; t < 6; ++t) m = fmaxf(m, s[t]);
        m = wave_max(m);
        float l = 0.f;
#pragma unroll
        for (int t = 0; t < 6; ++t) { s[t] = __builtin_amdgcn_exp2f(s[t] - m); l += s[t]; }
        l = wave_sum(l);
        float o = 0.f;
#pragma unroll
        for (int t = 0; t < 6; ++t)
            for (int src = 0; src < 64; ++src) { const float pv = __shfl(s[t], src); const int ktok = __shfl(kt[t], src);
                const float v = bflo((unsigned)Vb[(size_t)ktok * 1024 + h * 64 + lane]); o += pv * v; }
        const float sg = bflo((unsigned)SGb[(size_t)tok * 1024 + h * 64 + lane]);
        const float z = o / l * sg;
        Z[(size_t)tok * 1024 + h * 64 + lane] = (bf16_t)(cvtpk(z, 0.f) & 0xffffu);
    }
}

constexpr int NPHASE = 17;
__global__ void __launch_bounds__(NWAVES * 64, 2) fwd_mega(Args args) {
    extern __shared__ __attribute__((aligned(16))) unsigned char lds[];
    Frame F;
    F.lds = (LAS unsigned char*)lds;
    F.MISC = (volatile LAS unsigned*)(F.lds + MISC_OFF);
    F.tid = threadIdx.x; F.lane = F.tid & 63; F.wave = __builtin_amdgcn_readfirstlane(F.tid >> 6);
    F.G = gridDim.x; { const int bx = blockIdx.x; F.vcu = (F.G % 8 == 0) ? (bx % 8) * (F.G / 8) + bx / 8 : bx; }
    F.x = args.in[0]; F.c = args.in[1]; F.ctx = args.in[2]; F.c_ctx = args.in[3]; F.norm_g = args.in[4]; F.ada_w = args.in[5]; F.ada_b = args.in[6];
    F.pool_w_in = args.in[7]; F.pool_w_grp = args.in[8]; F.pool_scale = args.in[9]; F.pool_w_out = args.in[10]; F.na_w_in = args.in[11]; F.na_rpb = args.in[12]; F.na_w_out = args.in[13];
    F.conv_w_in = args.in[14]; F.conv_dw = args.in[15]; F.conv_db = args.in[16]; F.conv_w_out = args.in[17]; F.final_g = args.in[18];
    F.out = args.out; F.ws = args.ws;
    unsigned char* ws = args.ws;
    F.MOD = (float*)(ws + WS_MOD); F.CVEC = (float*)(ws + WS_CVEC); F.SSQ = (float*)(ws + WS_SSQ); F.XC = (float*)(ws + WS_XC);
    F.WPIN = (bf16_t*)(ws + WS_WPIN); F.WGRP = (bf16_t*)(ws + WS_WGRP); F.WPOUT = (bf16_t*)(ws + WS_WPOUT); F.WNIN = (bf16_t*)(ws + WS_WNIN); F.WNOUT = (bf16_t*)(ws + WS_WNOUT);
    F.WCIN = (bf16_t*)(ws + WS_WCIN); F.WCOUT = (bf16_t*)(ws + WS_WCOUT); F.XT = (bf16_t*)(ws + WS_XT); F.ACT0 = (bf16_t*)(ws + WS_ACT0);
    constexpr size_t AS = ACT_STRIDE / 2;
    bf16_t* const A0 = F.ACT0; bf16_t* const A1 = F.ACT0 + AS; bf16_t* const A2 = F.ACT0 + 2 * AS; bf16_t* const A3 = F.ACT0 + 3 * AS;

    for (int u = F.tid; u < (LDS_BYTES - LDSCTL_OFF) / 4; u += NWAVES * 64) ((LAS unsigned*)(F.lds + LDSCTL_OFF))[u] = 0u;
    __syncthreads();
    unsigned* barw = (unsigned*)(ws + WS_CTL) + CW_BAR;
    XcdBarrier bar; bar.bar = barw; bar.x = 0; bar.st = nullptr;
    if (!MK_PER_PHASE) bar = xcd_barrier_post(barw, F.MISC + 8);
    const int lo = args.ph_lo, hi = args.ph_hi;
#define IN(k) (lo <= (k) && (k) < hi)
#define SEAM(k) do { if (IN(k) && IN((k) + 1)) xcd_barrier(bar); } while (0)
    typedef pg8::StaticOrder SO;
    const int bid = (int)blockIdx.x;

    if (IN(0)) { p0_prologue(F); } SEAM(0);
    if (IN(1)) { p1_prep(F); } SEAM(1);

#define POOL_LAYER(PH, LI, PJ, MROWS) \
    if (IN(PH)) { pg8::Gemm g{F.XT, F.WPIN + (size_t)(PJ) * 2048 * 1024, (MROWS), 2048, 1024, 1024, 1024, 0}; SO S; S.init((MROWS), 2048, F.G, bid); \
        pg8::EpiPool1 E{F.SSQ, F.CVEC + (size_t)(LI) * 9 * 4096, F.pool_scale + (PJ) * 1024, A0, A1}; \
        pg8::gemm_phase<pg8::EpiPool1, SO>(F.lds, g, S, E); } SEAM(PH); \
    if (IN((PH) + 1)) { e_pool(F, A0, A2, (MROWS)); } SEAM((PH) + 1); \
    if (IN((PH) + 2)) { pg8::Gemm g{A2, F.WGRP + (size_t)(PJ) * 4 * 65536, (MROWS), 1024, 256, 1024, 256, 256}; SO S; S.init((MROWS), 1024, F.G, bid); \
        pg8::EpiPool2 E{A1, A3}; \
        pg8::gemm_phase<pg8::EpiPool2, SO>(F.lds, g, S, E); } SEAM((PH) + 2);

    POOL_LAYER(2, 0, 0, MT)
    if (IN(5)) { pg8::Gemm g{A3, F.WPOUT, MT, 1024, 1024, 1024, 1024, 0}; SO S; S.init(MT, 1024, F.G, bid);
        pg8::EpiOut E{F.x, F.ctx, F.out, F.XC, F.MOD + 0 * 9 * 3072 + 2048, F.norm_g + 1024, F.MOD + 1 * 9 * 3072 + 1024, F.XT, F.SSQ};
        pg8::gemm_phase<pg8::EpiOut, SO>(F.lds, g, S, E); } SEAM(5);

    if (IN(6)) {
        { pg8::Gemm g{F.XT, F.WNIN, MX, 4096, 1024, 1024, 1024, 0}; SO S; S.init(MX, 4096, F.G, bid);
          pg8::EpiNa1 E{F.SSQ, F.CVEC + (size_t)1 * 9 * 4096, A0, AS, 0, -1};
          pg8::gemm_phase<pg8::EpiNa1, SO>(F.lds, g, S, E); }
        { pg8::Gemm g{F.XT + (size_t)MX * 1024, F.WNIN + (size_t)1024 * 1024, MC, 2048, 1024, 1024, 1024, 0}; SO S; S.init(MC, 2048, F.G, (bid + 128) % F.G);
          pg8::EpiNa1 E{F.SSQ + (size_t)MX * 16, F.CVEC + (size_t)1 * 9 * 4096 + 1024, A0 + (size_t)MX * 1024, AS, 1, 8};
          pg8::gemm_phase<pg8::EpiNa1, SO>(F.lds, g, S, E); }
    } SEAM(6);
    if (IN(7)) { attn_naive(F, A0, A1, A2, A3, A0); } SEAM(7);
    if (IN(8)) { pg8::Gemm g{A0, F.WNOUT, MX, 1024, 1024, 1024, 1024, 0}; SO S; S.init(MX, 1024, F.G, bid);
        pg8::EpiOut E{F.out, F.XC, F.out, F.XC, F.MOD + 1 * 9 * 3072 + 2048, F.norm_g + 2048, F.MOD + 2 * 9 * 3072 + 1024, F.XT, F.SSQ};
        pg8::gemm_phase<pg8::EpiOut, SO>(F.lds, g, S, E); } SEAM(8);

    if (IN(9)) { pg8::Gemm g{F.XT, F.WCIN, MX, 4096, 1024, 1024, 1024, 0}; SO S; S.init(MX, 4096, F.G, bid);
        pg8::EpiConv1 E{F.SSQ, F.CVEC + (size_t)2 * 9 * 4096, A0, A1};
        pg8::gemm_phase<pg8::EpiConv1, SO>(F.lds, g, S, E); } SEAM(9);
    if (IN(10)) { e_conv(F, A0, A1, A2); } SEAM(10);
    if (IN(11)) { pg8::Gemm g{A2, F.WCOUT, MX, 1024, 1024, 1024, 1024, 0}; SO S; S.init(MX, 1024, F.G, bid);
        pg8::EpiOut E{F.out, F.XC, F.out, F.XC, F.MOD + 2 * 9 * 3072 + 2048, F.norm_g + 3072, F.MOD + 3 * 9 * 3072 + 1024, F.XT, F.SSQ};
        pg8::gemm_phase<pg8::EpiOut, SO>(F.lds, g, S, E); } SEAM(11);

    POOL_LAYER(12, 3, 1, MX)
    if (IN(15)) { pg8::Gemm g{A3, F.WPOUT + (size_t)1024 * 1024, MX, 1024, 1024, 1024, 1024, 0}; SO S; S.init(MX, 1024, F.G, bid);
        pg8::EpiOut E{F.out, F.XC, F.out, F.XC, F.MOD + 3 * 9 * 3072 + 2048, nullptr, nullptr, F.XT, F.SSQ};
        pg8::gemm_phase<pg8::EpiOut, SO>(F.lds, g, S, E); } SEAM(15);
    if (IN(16)) { e_final(F); }
#undef IN
#undef SEAM
}

extern "C" void kernel_launch(void* const* d_in, const int* in_sizes, int n_in, void* d_out, int out_size, void* d_ws, size_t ws_size, hipStream_t stream) {
    static int grid = 0;
    if (grid == 0) {
        if (n_in != 19 || out_size != MX * DM || ws_size < WS_END) { fprintf(stderr, "kernel_launch: unexpected shapes (n_in %d, out %d, ws %zu); nothing launched\n", n_in, out_size, ws_size); grid = -1; return; }
        int dev = 0, cus = 0, per_cu = 0;
        if (hipGetDevice(&dev) != hipSuccess || hipDeviceGetAttribute(&cus, hipDeviceAttributeMultiprocessorCount, dev) != hipSuccess) { grid = -1; return; }
        if (hipFuncSetAttribute((const void*)fwd_mega, hipFuncAttributeMaxDynamicSharedMemorySize, LDS_BYTES) != hipSuccess) { fprintf(stderr, "kernel_launch: hipFuncSetAttribute failed\n"); grid = -1; return; }
        if (hipOccupancyMaxActiveBlocksPerMultiprocessor(&per_cu, (const void*)fwd_mega, NWAVES * 64, LDS_BYTES) != hipSuccess || per_cu < 1) { fprintf(stderr, "kernel_launch: occupancy query reports %d workgroups per CU\n", per_cu); (void)hipGetLastError(); grid = -1; return; }
        grid = cus;
    }
    if (grid < 0) return;
    (void)hipMemsetAsync((char*)d_ws + WS_CTL, 0, CTL_ZERO_BYTES, stream);
    Args a{};
    for (int i = 0; i < 19; ++i) a.in[i] = (const float*)d_in[i];
    a.out = (float*)d_out; a.ws = (unsigned char*)d_ws;
#if MK_PER_PHASE
    for (int p = 0; p < NPHASE; ++p) { a.ph_lo = p; a.ph_hi = p + 1; hipLaunchKernelGGL(fwd_mega, dim3(grid), dim3(NWAVES * 64), LDS_BYTES, stream, a); }
#else
    a.ph_lo = 0; a.ph_hi = NPHASE;
    hipLaunchKernelGGL(fwd_mega, dim3(grid), dim3(NWAVES * 64), LDS_BYTES, stream, a);
#endif
}
```

```cpp
#include <hip/hip_runtime.h>
#include <cstdio>
#include <cstdint>

#ifndef MK_PER_PHASE
#define MK_PER_PHASE 0
#endif
#ifndef MK_NAIVE_ATTN
#define MK_NAIVE_ATTN 0
#endif

#define GAS __attribute__((address_space(1)))
#define LAS __attribute__((address_space(3)))
typedef unsigned short bf16_t;
typedef short bf16x8 __attribute__((ext_vector_type(8)));
typedef float f32x4 __attribute__((ext_vector_type(4)));
typedef unsigned u32x4 __attribute__((ext_vector_type(4)));
typedef unsigned u32x2 __attribute__((ext_vector_type(2)));
typedef float f32x2_t __attribute__((ext_vector_type(2)));
typedef __bf16 bf16x2_t __attribute__((ext_vector_type(2)));

constexpr int DM = 1024, NB = 8, SEQ = 2048, CTXL = 256;
constexpr int MX = NB * SEQ;
constexpr int MC = NB * CTXL;
constexpr int MT = MX + MC;
constexpr float EPS = 1e-6f;
constexpr float LOG2E = 1.4426950408889634f;
constexpr float QSCALE = 0.125f * LOG2E;

__device__ __forceinline__ unsigned cvtpk(float lo, float hi) { f32x2_t v = {lo, hi}; bf16x2_t b = __builtin_convertvector(v, bf16x2_t); return __builtin_bit_cast(unsigned, b); }
__device__ __forceinline__ float bflo(unsigned u) { return __builtin_bit_cast(float, u << 16); }
__device__ __forceinline__ float bfhi(unsigned u) { return __builtin_bit_cast(float, u & 0xffff0000u); }
__device__ __forceinline__ float silu_f(float v) { return v * __builtin_amdgcn_rcpf(1.0f + __builtin_amdgcn_exp2f(-LOG2E * v)); }
__device__ __forceinline__ float wave_sum(float v) {
#pragma unroll
    for (int o = 1; o < 64; o <<= 1) v += __shfl_xor(v, o);
    return v;
}
__device__ __forceinline__ float wave_max(float v) {
#pragma unroll
    for (int o = 1; o < 64; o <<= 1) v = fmaxf(v, __shfl_xor(v, o));
    return v;
}

namespace pg8 {
#define PG8_LAS __attribute__((address_space(3)))
constexpr int BM = 256, BK = 64, HALF = 128, HTB = HALF * BK * 2, STAGE_BYTES = 8 * HTB, NXCD = 8, WGM = 8;

__host__ __device__ __forceinline__ int lds_byte(int r, int c) { const int st = (r >> 4) * 2 + (c >> 5), rr = r & 15, cc = c & 31, ob = rr * 64 + cc * 2; return st * 1024 + (ob ^ (((ob >> 9) & 1) << 5)); }
__host__ __device__ __forceinline__ void stage_rc(int b, int& R, int& C) { const int st = b / 1024, sb = b % 1024, swz = sb ^ (((sb >> 9) & 1) << 5); R = (st >> 1) * 16 + swz / 64; C = (st & 1) * 32 + (swz % 64) / 2; }
__host__ __device__ __forceinline__ int perm32(int rho) { const int n = rho >> 4, i = rho & 15; return 8 * (i >> 2) + 4 * n + (i & 3); }

struct Unit { int pm, pn; };
struct Gemm { const bf16_t* A; const bf16_t* Bt; int M, N, K, lda, ldb, acol; };

struct StaticOrder {
    int nM, nN, nwg, G, c;
    __host__ __device__ void init(int M, int N, int G_, int c_) { nM = M / BM; nN = N / BM; nwg = nM * nN; G = G_; c = c_; }
    __host__ __device__ bool next(int i, Unit& u) const {
        const long L = (long)i * G + c; if (L >= nwg) return false;
        int wgid = (int)L; { const int q = nwg / NXCD, r = nwg % NXCD, xcd = wgid % NXCD, off = wgid / NXCD; wgid = (xcd < r ? xcd * (q + 1) : r * (q + 1) + (xcd - r) * q) + off; }
        const int nig = WGM * nN, gid = wgid / nig, fm = gid * WGM, gsz = (nM - fm) < WGM ? (nM - fm) : WGM;
        u.pm = fm + ((wgid % nig) % gsz); u.pn = (wgid % nig) / gsz; return true;
    }
};

template <class Epi, class Sched, bool ALIGN_EPI = true>
__device__ __forceinline__ void gemm_phase(PG8_LAS unsigned char* lds, const Gemm g, const Sched& S, const Epi& E) {
    const int tid = threadIdx.x, wid = __builtin_amdgcn_readfirstlane(tid >> 6), lane = tid & 63, wr = wid >> 2, wc = wid & 3, fr = lane & 15, fq = lane >> 4;
    const int K = g.K, nt = K / BK;
    unsigned voffA[2], voffB[2];
#pragma unroll
    for (int i = 0; i < 2; ++i) { int R, C; stage_rc(tid * 16 + i * 8192, R, C); const int Rb = Epi::PERM ? ((R & ~31) + perm32(R & 31)) : R;
        voffA[i] = (unsigned)(R * g.lda + C) * 2u; voffB[i] = (unsigned)(Rb * g.ldb + C) * 2u; }
    const size_t kstep = (size_t)(BK * 2);
    const size_t hstepA = (size_t)HALF * g.lda * 2, hstepB = (size_t)HALF * g.ldb * 2;
    const size_t tstepA = 2 * hstepA, tstepB = 2 * hstepB;
    const unsigned ldsw = (unsigned)wid * 1024u;
    const int aoff = lds_byte(wr * 64 + fr, fq * 8), boff = lds_byte(wc * 32 + fr, fq * 8);
#define PG8_SA(b, h) (((b) * 2 + (h)) * HTB)
#define PG8_SB(b, h) ((4 + (b) * 2 + (h)) * HTB)
#define PG8_STAGE(bufoff, gbase, voff) do { _Pragma("unroll") for (int _i = 0; _i < 2; ++_i) \
        __builtin_amdgcn_global_load_lds((const unsigned*)((const char*)(gbase) + (voff)[_i]), (PG8_LAS unsigned*)(lds + (bufoff) + ldsw + _i * 8192), 16, 0, 0); } while (0)
#define PG8_LDA(dst, b, h) do { _Pragma("unroll") for (int m = 0; m < 4; ++m) _Pragma("unroll") for (int k = 0; k < 2; ++k) dst[m][k] = *(const PG8_LAS bf16x8*)(lds + PG8_SA(b, h) + aoff + m * 2048 + k * 1024); } while (0)
#define PG8_LDB(dst, b, h) do { _Pragma("unroll") for (int n = 0; n < 2; ++n) _Pragma("unroll") for (int k = 0; k < 2; ++k) dst[n][k] = *(const PG8_LAS bf16x8*)(lds + PG8_SB(b, h) + boff + n * 2048 + k * 1024); } while (0)
#define PG8_MMA(ai, bj, At, Bt) do { __builtin_amdgcn_s_setprio(1); _Pragma("unroll") for (int m = 0; m < 4; ++m) _Pragma("unroll") for (int n = 0; n < 2; ++n) _Pragma("unroll") for (int k = 0; k < 2; ++k) \
        acc[ai][bj][m][n] = __builtin_amdgcn_mfma_f32_16x16x32_bf16(Bt[n][k], At[m][k], acc[ai][bj][m][n], 0, 0, 0); __builtin_amdgcn_s_setprio(0); } while (0)
#define PG8_WAIT_V(n) asm volatile("s_waitcnt vmcnt(" #n ")" ::: "memory")
#define PG8_WAIT_L(n) asm volatile("s_waitcnt lgkmcnt(" #n ")" ::: "memory")
#define PG8_BAR __builtin_amdgcn_s_barrier()
#define PG8_SCHED __builtin_amdgcn_sched_barrier(0)
    Unit cur, nxt; int ui = 0;
    if (!S.next(0, cur)) return;
    f32x4 acc[2][2][4][2];
#pragma unroll
    for (int a = 0; a < 2; ++a)
#pragma unroll
        for (int b = 0; b < 2; ++b)
#pragma unroll
            for (int m = 0; m < 4; ++m)
#pragma unroll
                for (int n = 0; n < 2; ++n) acc[a][b][m][n] = (f32x4){0.f, 0.f, 0.f, 0.f};
    bf16x8 At[4][2], B0[2][2], B1[2][2];
    const char* cA = (const char*)g.A + (size_t)cur.pm * tstepA + (size_t)cur.pn * g.acol * 2; const char* cB = (const char*)g.Bt + (size_t)cur.pn * tstepB;
    PG8_STAGE(PG8_SB(0, 0), cB, voffB); PG8_STAGE(PG8_SB(0, 1), cB + hstepB, voffB); PG8_STAGE(PG8_SA(0, 0), cA, voffA); PG8_STAGE(PG8_SA(0, 1), cA + hstepA, voffA);
    if (wr == 1) PG8_BAR;
    PG8_WAIT_V(2); PG8_BAR;
    PG8_STAGE(PG8_SB(1, 0), cB + kstep, voffB); PG8_STAGE(PG8_SA(1, 0), cA + kstep, voffA); PG8_STAGE(PG8_SB(1, 1), cB + hstepB + kstep, voffB);
    PG8_WAIT_V(6); PG8_BAR;
    for (;;) {
        const bool has_next = S.next(ui + 1, nxt);
        const char* nA = has_next ? (const char*)g.A + (size_t)nxt.pm * tstepA + (size_t)nxt.pn * g.acol * 2 : cA; const char* nB = has_next ? (const char*)g.Bt + (size_t)nxt.pn * tstepB : cB;
        for (int t = 0; t < nt; t += 2) {
            const bool last = (t == nt - 2);
            const char* a1 = cA + (size_t)(t + 1) * kstep;
            const char* a2 = last ? nA : cA + (size_t)(t + 2) * kstep; const char* b2 = last ? nB : cB + (size_t)(t + 2) * kstep;
            const char* a3 = a2 + kstep; const char* b3 = b2 + kstep;
            PG8_LDB(B0, 0, 0); PG8_LDB(B1, 0, 1); PG8_SCHED; PG8_LDA(At, 0, 0); PG8_STAGE(PG8_SA(1, 1), a1 + hstepA, voffA);
            PG8_WAIT_V(8); PG8_WAIT_L(0); PG8_BAR; PG8_MMA(0, 0, At, B0); PG8_MMA(0, 1, At, B1); PG8_BAR; PG8_SCHED;
            PG8_LDA(At, 0, 1); PG8_STAGE(PG8_SB(0, 0), b2, voffB); PG8_STAGE(PG8_SB(0, 1), b2 + hstepB, voffB); PG8_STAGE(PG8_SA(0, 0), a2, voffA);
            PG8_WAIT_V(8); PG8_WAIT_L(0); PG8_BAR; PG8_MMA(1, 0, At, B0); PG8_MMA(1, 1, At, B1); PG8_BAR; PG8_SCHED;
            PG8_LDB(B0, 1, 0); PG8_LDB(B1, 1, 1); PG8_SCHED; PG8_LDA(At, 1, 0); PG8_STAGE(PG8_SA(0, 1), a2 + hstepA, voffA);
            PG8_WAIT_V(8); PG8_WAIT_L(0); PG8_BAR; PG8_MMA(0, 0, At, B0); PG8_MMA(0, 1, At, B1); PG8_BAR; PG8_SCHED;
            PG8_LDA(At, 1, 1); PG8_STAGE(PG8_SB(1, 0), b3, voffB); PG8_STAGE(PG8_SB(1, 1), b3 + hstepB, voffB); PG8_STAGE(PG8_SA(1, 0), a3, voffA);
            PG8_WAIT_V(8); PG8_WAIT_L(0); PG8_BAR; PG8_MMA(1, 0, At, B0); PG8_MMA(1, 1, At, B1); PG8_BAR; PG8_SCHED;
        }
        if constexpr (ALIGN_EPI) { if (wr == 0) PG8_BAR; }
        E(acc, cur, wr, wc, fr, fq);
        if (!has_next) break;
#pragma unroll
        for (int a = 0; a < 2; ++a)
#pragma unroll
            for (int b = 0; b < 2; ++b)
#pragma unroll
                for (int m = 0; m < 4; ++m)
#pragma unroll
                    for (int n = 0; n < 2; ++n) acc[a][b][m][n] = (f32x4){0.f, 0.f, 0.f, 0.f};
        cur = nxt; cA = nA; cB = nB; ++ui;
        if constexpr (ALIGN_EPI) { if (wr == 1) PG8_BAR; }
    }
    PG8_WAIT_V(0);
    if constexpr (!ALIGN_EPI) { if (wr == 0) PG8_BAR; }
    PG8_BAR;
#undef PG8_SA
#undef PG8_SB
#undef PG8_STAGE
#undef PG8_LDA
#undef PG8_LDB
#undef PG8_MMA
#undef PG8_WAIT_V
#undef PG8_WAIT_L
#undef PG8_BAR
#undef PG8_SCHED
}

__device__ __forceinline__ float row_rstd(const float* ssq, int row) {
    const f32x4* p = (const f32x4*)(ssq + (size_t)row * 16);
    const f32x4 a = p[0], b = p[1], c = p[2], d = p[3];
    const float s = ((a.x + a.y) + (a.z + a.w)) + ((b.x + b.y) + (b.z + b.w)) + ((c.x + c.y) + (c.z + c.w)) + ((d.x + d.y) + (d.z + d.w));
    return rsqrtf(s * (1.0f / 1024.0f) + EPS);
}
__device__ __forceinline__ u32x4 pack8(const f32x4 v0, const f32x4 v1) { u32x4 w; w.x = cvtpk(v0[0], v0[1]); w.y = cvtpk(v0[2], v0[3]); w.z = cvtpk(v1[0], v1[1]); w.w = cvtpk(v1[2], v1[3]); return w; }

struct EpiPool1 {
    static constexpr bool PERM = true;
    const float* ssq; const float* cvec; const float* pscale; bf16_t* U; bf16_t* SG;
    __device__ __forceinline__ void operator()(const f32x4 (&acc)[2][2][4][2], const Unit& u, int wr, int wc, int fr, int fq) const {
        const int bm = u.pm < 64 ? (u.pm >> 3) : 8;
        const bool isg = u.pn >= 4;
        const int ct = u.pn * 256 + wc * 32 + 8 * fq, co = (u.pn & 3) * 256 + wc * 32 + 8 * fq;
        f32x4 cv[2][2], sc[2][2];
#pragma unroll
        for (int bj = 0; bj < 2; ++bj)
#pragma unroll
            for (int n = 0; n < 2; ++n) { cv[bj][n] = *(const f32x4*)(cvec + (size_t)bm * 4096 + ct + bj * 128 + 4 * n);
                sc[bj][n] = isg ? *(const f32x4*)(pscale + co + bj * 128 + 4 * n) : (f32x4){1.f, 1.f, 1.f, 1.f}; }
        bf16_t* O = isg ? SG : U;
#pragma unroll
        for (int ai = 0; ai < 2; ++ai)
#pragma unroll
            for (int m = 0; m < 4; ++m) { const int row = u.pm * 256 + ai * 128 + wr * 64 + m * 16 + fr; const float rs = row_rstd(ssq, row);
#pragma unroll
                for (int bj = 0; bj < 2; ++bj) { f32x4 v0 = acc[ai][bj][m][0] * rs + cv[bj][0], v1 = acc[ai][bj][m][1] * rs + cv[bj][1];
                    if (isg) {
#pragma unroll
                        for (int j = 0; j < 4; ++j) { v0[j] = sc[bj][0][j] * silu_f(v0[j]); v1[j] = sc[bj][1][j] * silu_f(v1[j]); } }
                    *(u32x4*)(O + (size_t)row * 1024 + co + bj * 128) = pack8(v0, v1); }
                if (m & 1) asm volatile("" ::: "memory"); }
    }
};
struct EpiPool2 {
    static constexpr bool PERM = true;
    const bf16_t* SG; bf16_t* Z;
    __device__ __forceinline__ void operator()(const f32x4 (&acc)[2][2][4][2], const Unit& u, int wr, int wc, int fr, int fq) const {
        const int co = u.pn * 256 + wc * 32 + 8 * fq;
#pragma unroll
        for (int ai = 0; ai < 2; ++ai)
#pragma unroll
            for (int m = 0; m < 4; ++m) { const int row = u.pm * 256 + ai * 128 + wr * 64 + m * 16 + fr;
#pragma unroll
                for (int bj = 0; bj < 2; ++bj) { const u32x4 s = *(const u32x4*)(SG + (size_t)row * 1024 + co + bj * 128);
                    f32x4 v0 = acc[ai][bj][m][0], v1 = acc[ai][bj][m][1];
                    v0[0] *= bflo(s.x); v0[1] *= bfhi(s.x); v0[2] *= bflo(s.y); v0[3] *= bfhi(s.y);
                    v1[0] *= bflo(s.z); v1[1] *= bfhi(s.z); v1[2] *= bflo(s.w); v1[3] *= bfhi(s.w);
                    *(u32x4*)(Z + (size_t)row * 1024 + co + bj * 128) = pack8(v0, v1); }
                if (m & 1) asm volatile("" ::: "memory"); }
    }
};
struct EpiNa1 {
    static constexpr bool PERM = true;
    const float* ssq; const float* cvec; bf16_t* out; size_t tstride; int tbase; int bmfix;
    __device__ __forceinline__ void operator()(const f32x4 (&acc)[2][2][4][2], const Unit& u, int wr, int wc, int fr, int fq) const {
        const int bm = bmfix >= 0 ? bmfix : (u.pm >> 3);
        const int t = tbase + (u.pn >> 2);
        const int ct = u.pn * 256 + wc * 32 + 8 * fq, co = (u.pn & 3) * 256 + wc * 32 + 8 * fq;
        f32x4 cv[2][2];
#pragma unroll
        for (int bj = 0; bj < 2; ++bj)
#pragma unroll
            for (int n = 0; n < 2; ++n) cv[bj][n] = *(const f32x4*)(cvec + (size_t)bm * 4096 + ct + bj * 128 + 4 * n);
        bf16_t* O = out + (size_t)t * tstride;
#pragma unroll
        for (int ai = 0; ai < 2; ++ai)
#pragma unroll
            for (int m = 0; m < 4; ++m) { const int row = u.pm * 256 + ai * 128 + wr * 64 + m * 16 + fr; const float rs = row_rstd(ssq, row);
#pragma unroll
                for (int bj = 0; bj < 2; ++bj) { f32x4 v0 = acc[ai][bj][m][0] * rs + cv[bj][0], v1 = acc[ai][bj][m][1] * rs + cv[bj][1];
                    if (t == 0) { v0 = v0 * QSCALE; v1 = v1 * QSCALE; }
                    if (t == 3) {
#pragma unroll
                        for (int j = 0; j < 4; ++j) { v0[j] = silu_f(v0[j]); v1[j] = silu_f(v1[j]); } }
                    *(u32x4*)(O + (size_t)row * 1024 + co + bj * 128) = pack8(v0, v1); }
                if (m & 1) asm volatile("" ::: "memory"); }
    }
};
struct EpiConv1 {
    static constexpr bool PERM = true;
    const float* ssq; const float* cvec; bf16_t* P; bf16_t* S;
    __device__ __forceinline__ void operator()(const f32x4 (&acc)[2][2][4][2], const Unit& u, int wr, int wc, int fr, int fq) const {
        const int bm = u.pm >> 3;
        const int ct = u.pn * 256 + wc * 32 + 8 * fq, ch0 = u.pn * 64 + wc * 16 + 4 * fq;
        f32x4 cv[2][2];
#pragma unroll
        for (int bj = 0; bj < 2; ++bj)
#pragma unroll
            for (int n = 0; n < 2; ++n) cv[bj][n] = *(const f32x4*)(cvec + (size_t)bm * 4096 + ct + bj * 128 + 4 * n);
#pragma unroll
        for (int ai = 0; ai < 2; ++ai)
#pragma unroll
            for (int m = 0; m < 4; ++m) { const int row = u.pm * 256 + ai * 128 + wr * 64 + m * 16 + fr; const float rs = row_rstd(ssq, row);
                const f32x4 bg = acc[ai][0][m][0] * rs + cv[0][0], cg = acc[ai][0][m][1] * rs + cv[0][1], vv = acc[ai][1][m][0] * rs + cv[1][0], gg = acc[ai][1][m][1] * rs + cv[1][1];
                f32x4 p = cg * vv, s;
#pragma unroll
                for (int j = 0; j < 4; ++j) s[j] = bg[j] * silu_f(gg[j]);
                u32x2 pw, sw; pw.x = cvtpk(p[0], p[1]); pw.y = cvtpk(p[2], p[3]); sw.x = cvtpk(s[0], s[1]); sw.y = cvtpk(s[2], s[3]);
                *(u32x2*)(P + (size_t)row * 1024 + ch0) = pw; *(u32x2*)(S + (size_t)row * 1024 + ch0) = sw;
                if (m & 1) asm volatile("" ::: "memory"); }
    }
};
struct EpiOut {
    static constexpr bool PERM = false;
    const float* basex; const float* basec; float* outx; float* outc;
    const float* gate;
    const float* gnext;
    const float* scnext;
    bf16_t* XT; float* ssq;
    __device__ __forceinline__ void operator()(const f32x4 (&acc)[2][2][4][2], const Unit& u, int wr, int wc, int fr, int fq) const {
        const bool isc = u.pm >= 64; const int bm = isc ? 8 : (u.pm >> 3);
        const int col0 = u.pn * 256 + wc * 32 + 4 * fq;
        f32x4 gt[2][2], an[2][2];
#pragma unroll
        for (int bj = 0; bj < 2; ++bj)
#pragma unroll
            for (int n = 0; n < 2; ++n) { gt[bj][n] = *(const f32x4*)(gate + (size_t)bm * 3072 + col0 + bj * 128 + n * 16);
                if (gnext) an[bj][n] = *(const f32x4*)(gnext + col0 + bj * 128 + n * 16) * (*(const f32x4*)(scnext + (size_t)bm * 3072 + col0 + bj * 128 + n * 16) + 1.0f);
                else an[bj][n] = (f32x4){0.f, 0.f, 0.f, 0.f}; }
        const float* bp = isc ? basec - (size_t)MX * 1024 : basex; float* op = isc ? outc - (size_t)MX * 1024 : outx;
#pragma unroll
        for (int ai = 0; ai < 2; ++ai)
#pragma unroll
            for (int m = 0; m < 4; ++m) { const int row = u.pm * 256 + ai * 128 + wr * 64 + m * 16 + fr; const size_t off = (size_t)row * 1024 + col0; float s = 0.f;
#pragma unroll
                for (int bj = 0; bj < 2; ++bj)
#pragma unroll
                    for (int n = 0; n < 2; ++n) { const f32x4 x = *(const f32x4*)(bp + off + bj * 128 + n * 16); const f32x4 y = x + gt[bj][n] * acc[ai][bj][m][n];
                        *(f32x4*)(op + off + bj * 128 + n * 16) = y; s += (y[0] * y[0] + y[1] * y[1]) + (y[2] * y[2] + y[3] * y[3]);
                        if (gnext) { const f32x4 tt = y * an[bj][n]; u32x2 w; w.x = cvtpk(tt[0], tt[1]); w.y = cvtpk(tt[2], tt[3]); *(u32x2*)(XT + off + bj * 128 + n * 16) = w; } }
                s += __shfl_xor(s, 16); s += __shfl_xor(s, 32);
                if (fq == 0) ssq[(size_t)row * 16 + u.pn * 4 + wc] = s;
                asm volatile("" ::: "memory"); }
    }
};
}

constexpr size_t MiB = 1u << 20;
constexpr size_t WS_CTL = 0, CTL_ZERO_BYTES = 1 * MiB;
constexpr size_t WS_MOD = 1 * MiB;
constexpr size_t WS_CVEC = 2 * MiB;
constexpr size_t WS_SSQ = 3 * MiB;
constexpr size_t WS_WPIN = 6 * MiB;
constexpr size_t WS_WGRP = 14 * MiB;
constexpr size_t WS_WPOUT = 15 * MiB;
constexpr size_t WS_WNIN = 19 * MiB;
constexpr size_t WS_WNOUT = 27 * MiB;
constexpr size_t WS_WCIN = 29 * MiB;
constexpr size_t WS_WCOUT = 37 * MiB;
constexpr size_t WS_XC = 40 * MiB;
constexpr size_t WS_XT = 48 * MiB;
constexpr size_t WS_ACT0 = 84 * MiB, ACT_STRIDE = 36 * MiB;
constexpr size_t WS_END = 228 * MiB;
constexpr int CW_BAR = 4096;

#define XB_TMO      128
#define XB_XCNT(j)  (256  + 64 * (j))
#define XB_XSUB(j)  (1280 + 64 * (j))
#define XB_XGEN(j)  (2304 + 64 * (j))
#define XB_TOP      3328
#define XB_TOPGEN   3392
#define XCD_BAR_WORDS 3456
#define XB_SPIN_CAP (1u << 18)
__device__ __forceinline__ unsigned xb_ld(unsigned* p)              { return __hip_atomic_load(p, __ATOMIC_RELAXED, __HIP_MEMORY_SCOPE_AGENT); }
__device__ __forceinline__ unsigned xb_add(unsigned* p, unsigned v) { return __hip_atomic_fetch_add(p, v, __ATOMIC_RELAXED, __HIP_MEMORY_SCOPE_AGENT); }
__device__ __forceinline__ unsigned xb_xcc_id() { return (unsigned)__builtin_amdgcn_s_getreg((3 << 11) | 20) & 0xFu; }
#define XB_SPIN(cond, bar) do { unsigned _sp = 0; while (cond) { __builtin_amdgcn_s_sleep(1); \
    if ((++_sp & 255u) == 0u) { if (xb_ld(&(bar)[XB_TMO])) break; if (_sp > XB_SPIN_CAP) { atomicAdd(&(bar)[XB_TMO], 1u); break; } } } } while (0)
struct XcdBarrier { unsigned* bar; unsigned x; volatile LAS unsigned* st; };
__device__ __forceinline__ XcdBarrier xcd_barrier_post(unsigned* bar, volatile LAS unsigned* st) {
    XcdBarrier b; b.bar = bar; b.x = xb_xcc_id(); b.st = st;
    if (threadIdx.x == 0) (void)xb_add(&bar[XB_XCNT(b.x)], 1u);
    return b;
}
__device__ __forceinline__ void xcd_barrier_complete(unsigned* bar, unsigned x, unsigned& nloc, unsigned& nx) {
    const unsigned G = gridDim.x * gridDim.y * gridDim.z;
    unsigned sum, cnt, mine, sp = 0u;
    for (;;) {
        sum = 0u; cnt = 0u; mine = 0u;
#pragma unroll
        for (unsigned j = 0; j < 16; ++j) { const unsigned c = xb_ld(&bar[XB_XCNT(j)]); sum += c; cnt += (c > 0u) ? 1u : 0u; mine = (j == x) ? c : mine; }
        if (sum == G) break;
        __builtin_amdgcn_s_sleep(1);
        if ((++sp & 255u) == 0u) { if (xb_ld(&bar[XB_TMO])) break; if (sp > XB_SPIN_CAP) { atomicAdd(&bar[XB_TMO], 1u); break; } }
    }
    nloc = mine > 0u ? mine : 1u; nx = cnt > 0u ? cnt : 1u;
}
__device__ __forceinline__ void xcd_barrier(const XcdBarrier& b) {
    asm volatile("s_waitcnt vmcnt(0)" ::: "memory");
    __syncthreads();
    if (threadIdx.x == 0) {
        unsigned* bar = b.bar;
        __builtin_amdgcn_s_waitcnt(0);
        unsigned nloc = b.st[0], nx = b.st[1];
        if (nloc == 0u) { xcd_barrier_complete(bar, b.x, nloc, nx); b.st[0] = nloc; b.st[1] = nx; }
        const unsigned old = xb_add(&bar[XB_XSUB(b.x)], 1u);
        const unsigned gen = old / nloc;
        if (old + 1u == (gen + 1u) * nloc) {
            __builtin_amdgcn_fence(__ATOMIC_RELEASE, "agent");
            asm volatile("s_waitcnt vmcnt(0)" ::: "memory");
            const unsigned og = xb_add(&bar[XB_TOP], 1u);
            const unsigned tg = og / nx;
            if (og + 1u == (tg + 1u) * nx) xb_add(&bar[XB_TOPGEN], 1u);
            else XB_SPIN(xb_ld(&bar[XB_TOPGEN]) == tg, bar);
            __builtin_amdgcn_fence(__ATOMIC_ACQUIRE, "agent");
            xb_add(&bar[XB_XGEN(b.x)], 1u);
            asm volatile("s_waitcnt vmcnt(0)" ::: "memory");
        } else {
            XB_SPIN(xb_ld(&bar[XB_XGEN(b.x)]) == gen, bar);
            __builtin_amdgcn_fence(__ATOMIC_ACQUIRE, "agent");
            asm volatile("s_waitcnt vmcnt(0)" ::: "memory");
        }
    }
    __syncthreads();
}

constexpr int NWAVES = 8;
constexpr int RING_BYTES = 131072, LDSCTL_OFF = RING_BYTES, MISC_OFF = LDSCTL_OFF + 320, LDS_BYTES = 147456;

struct Args { const float* in[19]; float* out; unsigned char* ws; int ph_lo, ph_hi; };

struct Frame {
    LAS unsigned char* lds; volatile LAS unsigned* MISC;
    int tid, lane, wave, vcu, G;
    const float *x, *c, *ctx, *c_ctx, *norm_g, *ada_w, *ada_b, *pool_w_in, *pool_w_grp, *pool_scale, *pool_w_out, *na_w_in, *na_rpb, *na_w_out, *conv_w_in, *conv_dw, *conv_db, *conv_w_out, *final_g;
    float* out; unsigned char* ws;
    float *MOD, *CVEC, *SSQ, *XC;
    bf16_t *WPIN, *WGRP, *WPOUT, *WNIN, *WNOUT, *WCIN, *WCOUT, *XT, *ACT0;
};

__device__ __forceinline__ void p0_mod_task(Frame& F, int task) {
    const int layer = task / 48, col0 = (task % 48) * 64;
    LAS float* sc = (LAS float*)F.lds;
    LAS float* red = sc + 9 * 1024;
    for (int i = F.tid; i < 9 * 1024; i += NWAVES * 64) { const int b = i >> 10, k = i & 1023; const float v = (b < 8) ? F.c[b * 1024 + k] : F.c_ctx[k]; sc[i] = silu_f(v); }
    __syncthreads();
    const float* W = F.ada_w + (size_t)layer * 1024 * 3072 + col0;
    const int kr = F.lane >> 4, cl = (F.lane & 15) * 4;
    float acc[9][4];
#pragma unroll
    for (int b = 0; b < 9; ++b)
#pragma unroll
        for (int j = 0; j < 4; ++j) acc[b][j] = 0.f;
    const int kbase = F.wave * 128;
#pragma unroll 4
    for (int it = 0; it < 32; ++it) { const int k = kbase + it * 4 + kr; const f32x4 w = *(const f32x4*)(W + (size_t)k * 3072 + cl);
#pragma unroll
        for (int b = 0; b < 9; ++b) { const float s = sc[b * 1024 + k];
#pragma unroll
            for (int j = 0; j < 4; ++j) acc[b][j] += s * w[j]; } }
#pragma unroll
    for (int b = 0; b < 9; ++b)
#pragma unroll
        for (int j = 0; j < 4; ++j) { float v = acc[b][j]; v += __shfl_xor(v, 16); v += __shfl_xor(v, 32); acc[b][j] = v; }
    if (kr == 0) {
#pragma unroll
        for (int b = 0; b < 9; ++b)
#pragma unroll
            for (int j = 0; j < 4; ++j) red[(F.wave * 9 + b) * 64 + cl + j] = acc[b][j]; }
    __syncthreads();
    for (int o = F.tid; o < 576; o += NWAVES * 64) { const int b = o >> 6, cc = o & 63; float s = 0.f;
#pragma unroll
        for (int w = 0; w < 8; ++w) s += red[(w * 9 + b) * 64 + cc];
        F.MOD[(size_t)(layer * 9 + b) * 3072 + col0 + cc] = s + F.ada_b[layer * 3072 + col0 + cc]; }
    __syncthreads();
}
__device__ __forceinline__ unsigned f2bf(float f) { unsigned u = __builtin_bit_cast(unsigned, f); return (u + 0x7fffu + ((u >> 16) & 1u)) >> 16; }
__device__ __forceinline__ unsigned pk2(float lo, float hi) { return f2bf(lo) | (f2bf(hi) << 16); }
__device__ __forceinline__ int conv_row(int n) { const int split = n >> 10, ch = n & 1023; return (ch >> 6) * 256 + (split >> 1) * 128 + ((ch >> 4) & 3) * 32 + ((ch >> 2) & 3) * 8 + (split & 1) * 4 + (ch & 3); }
template <int MODE>
__device__ __forceinline__ void p0_transpose_item(const float* W, int K, int N, bf16_t* WT, LAS float* scr, int item, int lane) {
    const int nblk = N / 32, kb = item / nblk, nb = item % nblk, k0 = 64 * kb, n0 = 32 * nb;
#pragma unroll 8
    for (int i = 0; i < 32; ++i) { const int kk = 2 * i + (lane >> 5); scr[kk * 33 + (lane & 31)] = W[(size_t)(k0 + kk) * N + n0 + (lane & 31)]; }
    asm volatile("s_waitcnt lgkmcnt(0)" ::: "memory");
    const int c = lane & 7;
#pragma unroll
    for (int j = 0; j < 4; ++j) { const int n = (lane >> 3) + 8 * j; const LAS float* s = scr + (8 * c) * 33 + n;
        u32x4 o; o.x = pk2(s[0 * 33], s[1 * 33]); o.y = pk2(s[2 * 33], s[3 * 33]); o.z = pk2(s[4 * 33], s[5 * 33]); o.w = pk2(s[6 * 33], s[7 * 33]);
        const int drow = MODE == 1 ? conv_row(n0 + n) : (n0 + n);
        *(u32x4*)(WT + (size_t)drow * K + k0 + 8 * c) = o; }
    asm volatile("s_waitcnt lgkmcnt(0)" ::: "memory");
}
__device__ __forceinline__ void p0_prologue(Frame& F) {
    for (int t = (int)blockIdx.x; t < 192; t += F.G) p0_mod_task(F, t);
    LAS float* scr = (LAS float*)(F.lds + F.wave * 16384);
    const int gw = F.vcu * NWAVES + F.wave, NGW = F.G * NWAVES;
    constexpr int I_PIN = 16 * 64, I_GRP = 4 * 8, I_SQ = 16 * 32, I_BIG = 16 * 128;
    constexpr int NITEMS = 2 * I_PIN + 8 * I_GRP + 2 * I_SQ + I_BIG + I_SQ + I_BIG + I_SQ;
    for (int it = gw; it < NITEMS; it += NGW) {
        int r = it;
        if (r < 2 * I_PIN) { const int j = r / I_PIN; p0_transpose_item<0>(F.pool_w_in + (size_t)j * 1024 * 2048, 1024, 2048, F.WPIN + (size_t)j * 2048 * 1024, scr, r % I_PIN, F.lane); continue; } r -= 2 * I_PIN;
        if (r < 8 * I_GRP) { const int j = r / I_GRP; p0_transpose_item<0>(F.pool_w_grp + (size_t)j * 65536, 256, 256, F.WGRP + (size_t)j * 65536, scr, r % I_GRP, F.lane); continue; } r -= 8 * I_GRP;
        if (r < 2 * I_SQ) { const int j = r / I_SQ; p0_transpose_item<0>(F.pool_w_out + (size_t)j * 1024 * 1024, 1024, 1024, F.WPOUT + (size_t)j * 1024 * 1024, scr, r % I_SQ, F.lane); continue; } r -= 2 * I_SQ;
        if (r < I_BIG) { p0_transpose_item<0>(F.na_w_in, 1024, 4096, F.WNIN, scr, r, F.lane); continue; } r -= I_BIG;
        if (r < I_SQ) { p0_transpose_item<0>(F.na_w_out, 1024, 1024, F.WNOUT, scr, r, F.lane); continue; } r -= I_SQ;
        if (r < I_BIG) { p0_transpose_item<1>(F.conv_w_in, 1024, 4096, F.WCIN, scr, r, F.lane); continue; } r -= I_BIG;
        p0_transpose_item<0>(F.conv_w_out, 1024, 1024, F.WCOUT, scr, r, F.lane);
    }
}
__device__ __forceinline__ void p1_prep(Frame& F) {
    const int gw = F.vcu * NWAVES + F.wave, NGW = F.G * NWAVES, lane = F.lane;
    for (int task = gw; task < 12288; task += NGW) {
        int L, n; const bf16_t* WT;
        if (task < 2048) { L = 0; n = task; WT = F.WPIN; } else if (task < 6144) { L = 1; n = task - 2048; WT = F.WNIN; } else if (task < 10240) { L = 2; n = task - 6144; WT = F.WCIN; } else { L = 3; n = task - 10240; WT = F.WPIN + (size_t)2048 * 1024; }
        const u32x4 w0 = *(const u32x4*)(WT + (size_t)n * 1024 + lane * 8), w1 = *(const u32x4*)(WT + (size_t)n * 1024 + 512 + lane * 8);
        float wf[16] = {bflo(w0.x), bfhi(w0.x), bflo(w0.y), bfhi(w0.y), bflo(w0.z), bfhi(w0.z), bflo(w0.w), bfhi(w0.w), bflo(w1.x), bfhi(w1.x), bflo(w1.y), bfhi(w1.y), bflo(w1.z), bfhi(w1.z), bflo(w1.w), bfhi(w1.w)};
        const int nb = (L <= 1) ? 9 : 8;
        for (int b = 0; b < nb; ++b) { const float* sh = F.MOD + (size_t)(L * 9 + b) * 3072;
            const f32x4 s0 = *(const f32x4*)(sh + lane * 8), s1 = *(const f32x4*)(sh + lane * 8 + 4), s2 = *(const f32x4*)(sh + 512 + lane * 8), s3 = *(const f32x4*)(sh + 512 + lane * 8 + 4);
            float d = 0.f;
#pragma unroll
            for (int j = 0; j < 4; ++j) d += s0[j] * wf[j] + s1[j] * wf[4 + j] + s2[j] * wf[8 + j] + s3[j] * wf[12 + j];
            d = wave_sum(d);
            if (lane == 0) F.CVEC[(size_t)(L * 9 + b) * 4096 + n] = d; }
    }
    for (int row = gw; row < MT; row += NGW) {
        const float* src = row < MX ? F.x + (size_t)row * 1024 : F.ctx + (size_t)(row - MX) * 1024; const int bm = row < MX ? (row >> 11) : 8;
        const float* scl = F.MOD + (size_t)bm * 3072 + 1024;
        f32x4 v[4]; float ss = 0.f;
#pragma unroll
        for (int j = 0; j < 4; ++j) { v[j] = *(const f32x4*)(src + 256 * j + 4 * lane); ss += (v[j].x * v[j].x + v[j].y * v[j].y) + (v[j].z * v[j].z + v[j].w * v[j].w); }
        ss = wave_sum(ss);
        if (lane < 16) F.SSQ[(size_t)row * 16 + lane] = lane == 0 ? ss : 0.f;
#pragma unroll
        for (int j = 0; j < 4; ++j) { const f32x4 a = *(const f32x4*)(F.norm_g + 256 * j + 4 * lane) * (*(const f32x4*)(scl + 256 * j + 4 * lane) + 1.0f); const f32x4 t = v[j] * a;
            u32x2 w; w.x = cvtpk(t[0], t[1]); w.y = cvtpk(t[2], t[3]); *(u32x2*)(F.XT + (size_t)row * 1024 + 256 * j + 4 * lane) = w; }
    }
}
__device__ __forceinline__ void unpack8(const u32x4 w, float (&f)[8]) { f[0] = bflo(w.x); f[1] = bfhi(w.x); f[2] = bflo(w.y); f[3] = bfhi(w.y); f[4] = bflo(w.z); f[5] = bfhi(w.z); f[6] = bflo(w.w); f[7] = bfhi(w.w); }
__device__ __forceinline__ void e_pool(Frame& F, const bf16_t* U, bf16_t* A2, int nrows) {
    const int gt = F.vcu * (NWAVES * 64) + F.tid, NT = F.G * NWAVES * 64;
    const int nitems = (nrows / 16) * 128;
    for (int id = gt; id < nitems; id += NT) {
        const int col = (id & 127) * 8, r0 = (id >> 7) * 16;
        const int hw = 1 << (col >> 8);
        const int seq0 = r0 < MX ? (r0 & ~(SEQ - 1)) : MX + ((r0 - MX) & ~(CTXL - 1)); const int L = r0 < MX ? SEQ : CTXL;
        const int t0 = r0 - seq0;
        const bf16_t* base = U + (size_t)seq0 * 1024 + col;
        float S[8];
#pragma unroll
        for (int j = 0; j < 8; ++j) S[j] = 0.f;
        { const int lo = max(t0 - hw, 0), hi = min(t0 + hw, L);
          for (int t = lo; t < hi; ++t) { float f[8]; unpack8(*(const u32x4*)(base + (size_t)t * 1024), f);
#pragma unroll
              for (int j = 0; j < 8; ++j) S[j] += f[j]; } }
        for (int i = 0; i < 16; ++i) { const int t = t0 + i; const int lo = max(t - hw, 0), hi = min(t + hw, L); const float inv = 1.0f / (float)(hi - lo);
            float f[8]; unpack8(*(const u32x4*)(base + (size_t)t * 1024), f);
            f32x4 o0, o1;
#pragma unroll
            for (int j = 0; j < 4; ++j) { o0[j] = S[j] * inv - f[j]; o1[j] = S[4 + j] * inv - f[4 + j]; }
            *(u32x4*)(A2 + (size_t)(seq0 + t) * 1024 + col) = pg8::pack8(o0, o1);
            if (t + hw < L) { float a[8]; unpack8(*(const u32x4*)(base + (size_t)(t + hw) * 1024), a);
#pragma unroll
                for (int j = 0; j < 8; ++j) S[j] += a[j]; }
            if (t - hw >= 0) { float a[8]; unpack8(*(const u32x4*)(base + (size_t)(t - hw) * 1024), a);
#pragma unroll
                for (int j = 0; j < 8; ++j) S[j] -= a[j]; } }
    }
}
__device__ __forceinline__ void e_conv(Frame& F, const bf16_t* P, const bf16_t* Sg, bf16_t* Z) {
    const int gt = F.vcu * (NWAVES * 64) + F.tid, NT = F.G * NWAVES * 64;
    const int nitems = (MX / 16) * 128;
    for (int id = gt; id < nitems; id += NT) {
        const int col = (id & 127) * 8, r0 = (id >> 7) * 16, t0 = r0 & (SEQ - 1);
        float w0[8], w1[8], w2[8], bb[8];
#pragma unroll
        for (int h = 0; h < 2; ++h) { const f32x4 a = *(const f32x4*)(F.conv_dw + col + 4 * h), b = *(const f32x4*)(F.conv_dw + 1024 + col + 4 * h), c = *(const f32x4*)(F.conv_dw + 2048 + col + 4 * h), d = *(const f32x4*)(F.conv_db + col + 4 * h);
#pragma unroll
            for (int j = 0; j < 4; ++j) { w0[4 * h + j] = a[j]; w1[4 * h + j] = b[j]; w2[4 * h + j] = c[j]; bb[4 * h + j] = d[j]; } }
        float prev[8], cur[8], nxt[8];
        if (t0 > 0) unpack8(*(const u32x4*)(P + (size_t)(r0 - 1) * 1024 + col), prev); else {
#pragma unroll
            for (int j = 0; j < 8; ++j) prev[j] = 0.f; }
        unpack8(*(const u32x4*)(P + (size_t)r0 * 1024 + col), cur);
        for (int i = 0; i < 16; ++i) { const int t = t0 + i;
            if (t + 1 < SEQ) unpack8(*(const u32x4*)(P + (size_t)(r0 + i + 1) * 1024 + col), nxt); else {
#pragma unroll
                for (int j = 0; j < 8; ++j) nxt[j] = 0.f; }
            float s[8]; unpack8(*(const u32x4*)(Sg + (size_t)(r0 + i) * 1024 + col), s);
            f32x4 o0, o1;
#pragma unroll
            for (int j = 0; j < 4; ++j) { o0[j] = s[j] * (w0[j] * prev[j] + w1[j] * cur[j] + w2[j] * nxt[j] + bb[j]); o1[j] = s[4 + j] * (w0[4 + j] * prev[4 + j] + w1[4 + j] * cur[4 + j] + w2[4 + j] * nxt[4 + j] + bb[4 + j]); }
            *(u32x4*)(Z + (size_t)(r0 + i) * 1024 + col) = pg8::pack8(o0, o1);
#pragma unroll
            for (int j = 0; j < 8; ++j) { prev[j] = cur[j]; cur[j] = nxt[j]; } }
    }
}
__device__ __forceinline__ void e_final(Frame& F) {
    const int gw = F.vcu * NWAVES + F.wave, NGW = F.G * NWAVES, lane = F.lane;
    for (int row = gw; row < MX; row += NGW) {
        const float rs = pg8::row_rstd(F.SSQ, row);
#pragma unroll
        for (int j = 0; j < 4; ++j) { float* p = F.out + (size_t)row * 1024 + 256 * j + 4 * lane; const f32x4 v = *(const f32x4*)p; const f32x4 g = *(const f32x4*)(F.final_g + 256 * j + 4 * lane); *(f32x4*)p = v * rs * g; }
    }
}
__device__ __forceinline__ void attn_naive(Frame& F, const bf16_t* Q, const bf16_t* Kb, const bf16_t* Vb, const bf16_t* SGb, bf16_t* Z) {
    const int gw = F.vcu * NWAVES + F.wave, NGW = F.G * NWAVES, lane = F.lane;
    for (int task = gw; task < MX * 16; task += NGW) {
        const int tok = task >> 4, h = task & 15;
        const int b = tok >> 11, pos = tok & 2047, r = pos >> 6, col = pos & 63;
        const int rs = min(max(r - 4, 0), 24), cs = min(max(col - 8, 0), 48);
        const bf16_t* qp = Q + (size_t)tok * 1024 + h * 64;
        float s[6]; int kt[6];
#pragma unroll
        for (int t = 0; t < 6; ++t) {
            float bias = 0.f; int ktok;
            if (t < 2) { const int kk = lane + 64 * t, i = kk >> 4, jj = kk & 15; ktok = b * 2048 + (rs + i) * 64 + cs + jj;
                bias = F.na_rpb[(h * 15 + (rs + i - r + 7)) * 31 + (cs + jj - col + 15)] * LOG2E; }
            else { ktok = MX + b * 256 + lane + 64 * (t - 2); }
            kt[t] = ktok;
            const bf16_t* kp = Kb + (size_t)ktok * 1024 + h * 64; float d = 0.f;
#pragma unroll
            for (int d8 = 0; d8 < 8; ++d8) { float qf[8], kf[8]; unpack8(*(const u32x4*)(qp + d8 * 8), qf); unpack8(*(const u32x4*)(kp + d8 * 8), kf);
#pragma unroll
                for (int j = 0; j < 8; ++j) d += qf[j] * kf[j]; }
            s[t] = d + bias;
        }
        float m = s[0];
#pragma unroll
        for (int t = 1; t < 6; ++t) m = fmaxf(m, s[t]);
        m = wave_max(m);
        float l = 0.f;
#pragma unroll
        for (int t = 0; t < 6; ++t) { s[t] = __builtin_amdgcn_exp2f(s[t] - m); l += s[t]; }
        l = wave_sum(l);
        float o = 0.f;
#pragma unroll
        for (int t = 0; t < 6; ++t)
            for (int src = 0; src < 64; ++src) { const float pv = __shfl(s[t], src); const int ktok = __shfl(kt[t], src);
                const float v = bflo((unsigned)Vb[(size_t)ktok * 1024 + h * 64 + lane]); o += pv * v; }
        const float sg = bflo((unsigned)SGb[(size_t)tok * 1024 + h * 64 + lane]);
        const float z = o / l * sg;
        Z[(size_t)tok * 1024 + h * 64 + lane] = (bf16_t)(cvtpk(z, 0.f) & 0xffffu);
    }
}


namespace att {
using f32x16 = __attribute__((ext_vector_type(16))) float;
using s16x4 = __attribute__((ext_vector_type(4))) short;
typedef short v4i16_t __attribute__((ext_vector_type(4)));
typedef LAS const char* lds_cptr;
constexpr int L_K = 0, L_V = 16384, L_TAB = 32768, L_WS = 36864, L_OST = 40960;
constexpr float NEG = -1e30f;
constexpr float THR = 8.0f;
__device__ __forceinline__ int crow(int r, int hi) { return (r & 3) + 8 * (r >> 2) + 4 * hi; }
__device__ __forceinline__ s16x4 vtr(lds_cptr p) { return __builtin_bit_cast(s16x4, __builtin_amdgcn_ds_read_tr16_b64_v4i16((LAS v4i16_t*)p)); }
__device__ __forceinline__ float half_max(float m) { auto rr = __builtin_amdgcn_permlane32_swap(__float_as_uint(m), __float_as_uint(m), false, false); return fmaxf(__uint_as_float(rr[0]), __uint_as_float(rr[1])); }
__device__ __forceinline__ float half_sum(float m) { auto rr = __builtin_amdgcn_permlane32_swap(__float_as_uint(m), __float_as_uint(m), false, false); return __uint_as_float(rr[0]) + __uint_as_float(rr[1]); }

__device__ __forceinline__ void attn_unit(LAS unsigned char* lds, int b, int h, int r0, const bf16_t* Q, const bf16_t* Kb, const bf16_t* Vb, const bf16_t* SGb, bf16_t* Z, const float* rpb, int tid, int wid, int lane) {
    const int r32 = lane & 31, hi = lane >> 5;
    const int rq = r0 + (wid >> 1), colq = 32 * (wid & 1) + r32;
    const int rsw = min(max(rq - 4, 0), 24);
    const int kr_lo = min(max(r0 - 4, 0), 24), kr_hi = min(max(r0 + 3 - 4, 0), 24) + 7;
    const int NL = kr_hi - kr_lo + 1, NT = NL + 4;
    if (tid < 480) { const int row = tid >> 5, ci = tid & 31; ((LAS float*)(lds + L_TAB))[tid] = ci < 31 ? rpb[(h * 15 + row) * 31 + ci] * LOG2E : NEG; }
    unsigned boffp[8];
    { const int cs = min(max(colq - 8, 0), 48);
#pragma unroll
      for (int g = 0; g < 8; ++g) { unsigned pk = 0;
#pragma unroll
          for (int j = 0; j < 4; ++j) { const int r = (g & 3) * 4 + j; const int kc = crow(r, hi) + 32 * (g >> 2); const bool valid = (unsigned)(kc - cs) < 16u; const unsigned o = valid ? (unsigned)(kc - colq + 15) * 4u : 124u; pk |= o << (8 * j); }
          boffp[g] = pk; } }
    const size_t qtok = (size_t)b * SEQ + rq * 64 + colq;
    bf16x8 qr[4];
#pragma unroll
    for (int d0 = 0; d0 < 4; ++d0) qr[d0] = *(const bf16x8*)(Q + qtok * 1024 + h * 64 + d0 * 16 + hi * 8);
    const bf16_t* ksrc = Kb + (size_t)lane * 1024 + h * 64 + wid * 8;
    const bf16_t* vsrc = Vb + (size_t)(16 * (wid & 3) + (lane >> 2)) * 1024 + h * 64 + (wid >> 2) * 32 + (lane & 3) * 8;
#define ATT_TOK(t) ((t) < NL ? (size_t)b * SEQ + (size_t)(kr_lo + (t)) * 64 : (size_t)MX + (size_t)b * CTXL + (size_t)((t) - NL) * 64)
#define ATT_DMA(t) do { const size_t tk_ = ATT_TOK(t) * 1024; const int bo_ = ((t) & 1) * 8192; \
        __builtin_amdgcn_global_load_lds((const unsigned*)(ksrc + tk_), (LAS unsigned*)(lds + L_K + bo_ + wid * 1024), 16, 0, 0); \
        __builtin_amdgcn_global_load_lds((const unsigned*)(vsrc + tk_), (LAS unsigned*)(lds + L_V + bo_ + wid * 1024), 16, 0, 0); } while (0)
    ATT_DMA(0);
    f32x16 o0, o1;
#pragma unroll
    for (int r = 0; r < 16; ++r) { o0[r] = 0.f; o1[r] = 0.f; }
    float mref = NEG, lsum = 0.f;
    LAS float* wsf = (LAS float*)(lds + L_WS) + wid * 64;
    const lds_cptr kp0 = (lds_cptr)(lds + L_K) + hi * 1024 + r32 * 16;
    const lds_cptr vp0 = (lds_cptr)(lds + L_V) + ((lane >> 4) & 1) * 32 + (lane & 3) * 8 + (4 * hi + ((lane & 15) >> 2)) * 64;
    for (int t = 0; t < NT; ++t) {
        asm volatile("s_waitcnt vmcnt(0) lgkmcnt(0)" ::: "memory");
        __builtin_amdgcn_s_barrier();
        asm volatile("" ::: "memory");
        if (t + 1 < NT) ATT_DMA(t + 1);
        const bool local = t < NL; const int kr = kr_lo + t;
        const bool active = !local || (kr >= rsw && kr < rsw + 8);
        if (active) {
            const int bo = (t & 1) * 8192;
            f32x16 p0, p1;
#pragma unroll
            for (int r = 0; r < 16; ++r) { p0[r] = 0.f; p1[r] = 0.f; }
            { const lds_cptr kb = kp0 + bo;
#pragma unroll
              for (int d0 = 0; d0 < 4; ++d0) { const bf16x8 a0 = *(const LAS bf16x8*)(kb + d0 * 2048), a1 = *(const LAS bf16x8*)(kb + d0 * 2048 + 512);
                  p0 = __builtin_amdgcn_mfma_f32_32x32x16_bf16(a0, qr[d0], p0, 0, 0, 0); p1 = __builtin_amdgcn_mfma_f32_32x32x16_bf16(a1, qr[d0], p1, 0, 0, 0); } }
            if (local) { const lds_cptr tb = (lds_cptr)(lds + L_TAB) + (kr - rq + 7) * 128;
#pragma unroll
                for (int r = 0; r < 16; ++r) { p0[r] += *(const LAS float*)(tb + ((boffp[r >> 2] >> (8 * (r & 3))) & 0xffu)); p1[r] += *(const LAS float*)(tb + ((boffp[4 + (r >> 2)] >> (8 * (r & 3))) & 0xffu)); } }
            float mt = fmaxf(p0[0], p1[0]);
#pragma unroll
            for (int r = 1; r < 16; ++r) mt = fmaxf(mt, fmaxf(p0[r], p1[r]));
            mt = half_max(mt);
            if (__any(mt > mref + THR)) {
                const float mnew = fmaxf(mref, mt), alpha = __builtin_amdgcn_exp2f(mref - mnew);
                lsum *= alpha; mref = mnew;
                if (hi == 0) wsf[r32] = alpha;
                asm volatile("s_waitcnt lgkmcnt(0)" ::: "memory");
#pragma unroll
                for (int r = 0; r < 16; ++r) { const float f = wsf[crow(r, hi)]; o0[r] *= f; o1[r] *= f; }
            }
            float sacc = 0.f;
#pragma unroll
            for (int r = 0; r < 16; ++r) { p0[r] = __builtin_amdgcn_exp2f(p0[r] - mref); p1[r] = __builtin_amdgcn_exp2f(p1[r] - mref); sacc += p0[r] + p1[r]; }
            lsum += sacc;
            u32x4 pw0, pw1, pw2, pw3;
            pw0 = (u32x4){cvtpk(p0[0], p0[1]), cvtpk(p0[2], p0[3]), cvtpk(p0[4], p0[5]), cvtpk(p0[6], p0[7])};
            pw1 = (u32x4){cvtpk(p0[8], p0[9]), cvtpk(p0[10], p0[11]), cvtpk(p0[12], p0[13]), cvtpk(p0[14], p0[15])};
            pw2 = (u32x4){cvtpk(p1[0], p1[1]), cvtpk(p1[2], p1[3]), cvtpk(p1[4], p1[5]), cvtpk(p1[6], p1[7])};
            pw3 = (u32x4){cvtpk(p1[8], p1[9]), cvtpk(p1[10], p1[11]), cvtpk(p1[12], p1[13]), cvtpk(p1[14], p1[15])};
            const lds_cptr vp = vp0 + bo;
#define ATT_VF(i) ({ const s16x4 lo_ = vtr(vp + (((i) >> 2) * 4096 + ((i) & 3) * 1024)); const s16x4 hi_ = vtr(vp + (((i) >> 2) * 4096 + ((i) & 3) * 1024 + 512)); (bf16x8){lo_[0], lo_[1], lo_[2], lo_[3], hi_[0], hi_[1], hi_[2], hi_[3]}; })
            o0 = __builtin_amdgcn_mfma_f32_32x32x16_bf16(__builtin_bit_cast(bf16x8, pw0), ATT_VF(0), o0, 0, 0, 0);
            o1 = __builtin_amdgcn_mfma_f32_32x32x16_bf16(__builtin_bit_cast(bf16x8, pw0), ATT_VF(4), o1, 0, 0, 0);
            o0 = __builtin_amdgcn_mfma_f32_32x32x16_bf16(__builtin_bit_cast(bf16x8, pw1), ATT_VF(1), o0, 0, 0, 0);
            o1 = __builtin_amdgcn_mfma_f32_32x32x16_bf16(__builtin_bit_cast(bf16x8, pw1), ATT_VF(5), o1, 0, 0, 0);
            o0 = __builtin_amdgcn_mfma_f32_32x32x16_bf16(__builtin_bit_cast(bf16x8, pw2), ATT_VF(2), o0, 0, 0, 0);
            o1 = __builtin_amdgcn_mfma_f32_32x32x16_bf16(__builtin_bit_cast(bf16x8, pw2), ATT_VF(6), o1, 0, 0, 0);
            o0 = __builtin_amdgcn_mfma_f32_32x32x16_bf16(__builtin_bit_cast(bf16x8, pw3), ATT_VF(3), o0, 0, 0, 0);
            o1 = __builtin_amdgcn_mfma_f32_32x32x16_bf16(__builtin_bit_cast(bf16x8, pw3), ATT_VF(7), o1, 0, 0, 0);
#undef ATT_VF
        }
    }
#undef ATT_DMA
#undef ATT_TOK
    lsum = half_sum(lsum);
    if (hi == 0) wsf[32 + r32] = lsum;
    asm volatile("s_waitcnt lgkmcnt(0)" ::: "memory");
    LAS bf16_t* st = (LAS bf16_t*)(lds + L_OST) + wid * 2048;
#pragma unroll
    for (int r = 0; r < 16; ++r) { const int orow = crow(r, hi); const float rl = __builtin_amdgcn_rcpf(wsf[32 + orow]);
        st[orow * 64 + r32] = (bf16_t)(cvtpk(o0[r] * rl, 0.f) & 0xffffu); st[orow * 64 + 32 + r32] = (bf16_t)(cvtpk(o1[r] * rl, 0.f) & 0xffffu); }
    asm volatile("s_waitcnt lgkmcnt(0)" ::: "memory");
    const size_t tok0 = (size_t)b * SEQ + rq * 64 + 32 * (wid & 1);
#pragma unroll
    for (int i = 0; i < 4; ++i) { const int row = i * 8 + (lane >> 3), chn = lane & 7;
        const u32x4 v = *(const LAS u32x4*)(st + row * 64 + chn * 8); const size_t off = (tok0 + row) * 1024 + h * 64 + chn * 8;
        const u32x4 s = *(const u32x4*)(SGb + off);
        f32x4 a0, a1; a0[0] = bflo(v.x) * bflo(s.x); a0[1] = bfhi(v.x) * bfhi(s.x); a0[2] = bflo(v.y) * bflo(s.y); a0[3] = bfhi(v.y) * bfhi(s.y);
        a1[0] = bflo(v.z) * bflo(s.z); a1[1] = bfhi(v.z) * bfhi(s.z); a1[2] = bflo(v.w) * bflo(s.w); a1[3] = bfhi(v.w) * bfhi(s.w);
        *(u32x4*)(Z + off) = pg8::pack8(a0, a1); }
    asm volatile("s_waitcnt vmcnt(0) lgkmcnt(0)" ::: "memory");
    __builtin_amdgcn_s_barrier();
    asm volatile("" ::: "memory");
}
}
__device__ __forceinline__ void attn_mfma(Frame& F, const bf16_t* Q, const bf16_t* Kb, const bf16_t* Vb, const bf16_t* SGb, bf16_t* Z) {
    const int NU = NB * 16 * 8;
    const int per = (NU + F.G - 1) / F.G;
    for (int i = 0; i < per; ++i) { const int u = F.vcu * per + i; if (u >= NU) break;
        const int bh = u >> 3, rq4 = u & 7;
        att::attn_unit(F.lds, bh >> 4, bh & 15, rq4 * 4, Q, Kb, Vb, SGb, Z, F.na_rpb, F.tid, F.wave, F.lane); }
}

constexpr int NPHASE = 17;
__global__ void __launch_bounds__(NWAVES * 64, 2) fwd_mega(Args args) {
    extern __shared__ __attribute__((aligned(16))) unsigned char lds[];
    Frame F;
    F.lds = (LAS unsigned char*)lds;
    F.MISC = (volatile LAS unsigned*)(F.lds + MISC_OFF);
    F.tid = threadIdx.x; F.lane = F.tid & 63; F.wave = __builtin_amdgcn_readfirstlane(F.tid >> 6);
    F.G = gridDim.x; { const int bx = blockIdx.x; F.vcu = (F.G % 8 == 0) ? (bx % 8) * (F.G / 8) + bx / 8 : bx; }
    F.x = args.in[0]; F.c = args.in[1]; F.ctx = args.in[2]; F.c_ctx = args.in[3]; F.norm_g = args.in[4]; F.ada_w = args.in[5]; F.ada_b = args.in[6];
    F.pool_w_in = args.in[7]; F.pool_w_grp = args.in[8]; F.pool_scale = args.in[9]; F.pool_w_out = args.in[10]; F.na_w_in = args.in[11]; F.na_rpb = args.in[12]; F.na_w_out = args.in[13];
    F.conv_w_in = args.in[14]; F.conv_dw = args.in[15]; F.conv_db = args.in[16]; F.conv_w_out = args.in[17]; F.final_g = args.in[18];
    F.out = args.out; F.ws = args.ws;
    unsigned char* ws = args.ws;
    F.MOD = (float*)(ws + WS_MOD); F.CVEC = (float*)(ws + WS_CVEC); F.SSQ = (float*)(ws + WS_SSQ); F.XC = (float*)(ws + WS_XC);
    F.WPIN = (bf16_t*)(ws + WS_WPIN); F.WGRP = (bf16_t*)(ws + WS_WGRP); F.WPOUT = (bf16_t*)(ws + WS_WPOUT); F.WNIN = (bf16_t*)(ws + WS_WNIN); F.WNOUT = (bf16_t*)(ws + WS_WNOUT);
    F.WCIN = (bf16_t*)(ws + WS_WCIN); F.WCOUT = (bf16_t*)(ws + WS_WCOUT); F.XT = (bf16_t*)(ws + WS_XT); F.ACT0 = (bf16_t*)(ws + WS_ACT0);
    constexpr size_t AS = ACT_STRIDE / 2;
    bf16_t* const A0 = F.ACT0; bf16_t* const A1 = F.ACT0 + AS; bf16_t* const A2 = F.ACT0 + 2 * AS; bf16_t* const A3 = F.ACT0 + 3 * AS;

    for (int u = F.tid; u < (LDS_BYTES - LDSCTL_OFF) / 4; u += NWAVES * 64) ((LAS unsigned*)(F.lds + LDSCTL_OFF))[u] = 0u;
    __syncthreads();
    unsigned* barw = (unsigned*)(ws + WS_CTL) + CW_BAR;
    XcdBarrier bar; bar.bar = barw; bar.x = 0; bar.st = nullptr;
    if (!MK_PER_PHASE) bar = xcd_barrier_post(barw, F.MISC + 8);
    const int lo = args.ph_lo, hi = args.ph_hi;
#define IN(k) (lo <= (k) && (k) < hi)
#define SEAM(k) do { if (IN(k) && IN((k) + 1)) xcd_barrier(bar); } while (0)
    typedef pg8::StaticOrder SO;
    const int bid = (int)blockIdx.x;

    if (IN(0)) { p0_prologue(F); } SEAM(0);
    if (IN(1)) { p1_prep(F); } SEAM(1);

#define POOL_LAYER(PH, LI, PJ, MROWS) \
    if (IN(PH)) { pg8::Gemm g{F.XT, F.WPIN + (size_t)(PJ) * 2048 * 1024, (MROWS), 2048, 1024, 1024, 1024, 0}; SO S; S.init((MROWS), 2048, F.G, bid); \
        pg8::EpiPool1 E{F.SSQ, F.CVEC + (size_t)(LI) * 9 * 4096, F.pool_scale + (PJ) * 1024, A0, A1}; \
        pg8::gemm_phase<pg8::EpiPool1, SO>(F.lds, g, S, E); } SEAM(PH); \
    if (IN((PH) + 1)) { e_pool(F, A0, A2, (MROWS)); } SEAM((PH) + 1); \
    if (IN((PH) + 2)) { pg8::Gemm g{A2, F.WGRP + (size_t)(PJ) * 4 * 65536, (MROWS), 1024, 256, 1024, 256, 256}; SO S; S.init((MROWS), 1024, F.G, bid); \
        pg8::EpiPool2 E{A1, A3}; \
        pg8::gemm_phase<pg8::EpiPool2, SO>(F.lds, g, S, E); } SEAM((PH) + 2);

    POOL_LAYER(2, 0, 0, MT)
    if (IN(5)) { pg8::Gemm g{A3, F.WPOUT, MT, 1024, 1024, 1024, 1024, 0}; SO S; S.init(MT, 1024, F.G, bid);
        pg8::EpiOut E{F.x, F.ctx, F.out, F.XC, F.MOD + 0 * 9 * 3072 + 2048, F.norm_g + 1024, F.MOD + 1 * 9 * 3072 + 1024, F.XT, F.SSQ};
        pg8::gemm_phase<pg8::EpiOut, SO>(F.lds, g, S, E); } SEAM(5);

    if (IN(6)) {
        { pg8::Gemm g{F.XT, F.WNIN, MX, 4096, 1024, 1024, 1024, 0}; SO S; S.init(MX, 4096, F.G, bid);
          pg8::EpiNa1 E{F.SSQ, F.CVEC + (size_t)1 * 9 * 4096, A0, AS, 0, -1};
          pg8::gemm_phase<pg8::EpiNa1, SO>(F.lds, g, S, E); }
        { pg8::Gemm g{F.XT + (size_t)MX * 1024, F.WNIN + (size_t)1024 * 1024, MC, 2048, 1024, 1024, 1024, 0}; SO S; S.init(MC, 2048, F.G, (bid + 128) % F.G);
          pg8::EpiNa1 E{F.SSQ + (size_t)MX * 16, F.CVEC + (size_t)1 * 9 * 4096 + 1024, A0 + (size_t)MX * 1024, AS, 1, 8};
          pg8::gemm_phase<pg8::EpiNa1, SO>(F.lds, g, S, E); }
    } SEAM(6);
#if MK_NAIVE_ATTN
    if (IN(7)) { attn_naive(F, A0, A1, A2, A3, A0); } SEAM(7);
#else
    if (IN(7)) { attn_mfma(F, A0, A1, A2, A3, A0); } SEAM(7);
#endif
    if (IN(8)) { pg8::Gemm g{A0, F.WNOUT, MX, 1024, 1024, 1024, 1024, 0}; SO S; S.init(MX, 1024, F.G, bid);
        pg8::EpiOut E{F.out, F.XC, F.out, F.XC, F.MOD + 1 * 9 * 3072 + 2048, F.norm_g + 2048, F.MOD + 2 * 9 * 3072 + 1024, F.XT, F.SSQ};
        pg8::gemm_phase<pg8::EpiOut, SO>(F.lds, g, S, E); } SEAM(8);

    if (IN(9)) { pg8::Gemm g{F.XT, F.WCIN, MX, 4096, 1024, 1024, 1024, 0}; SO S; S.init(MX, 4096, F.G, bid);
        pg8::EpiConv1 E{F.SSQ, F.CVEC + (size_t)2 * 9 * 4096, A0, A1};
        pg8::gemm_phase<pg8::EpiConv1, SO>(F.lds, g, S, E); } SEAM(9);
    if (IN(10)) { e_conv(F, A0, A1, A2); } SEAM(10);
    if (IN(11)) { pg8::Gemm g{A2, F.WCOUT, MX, 1024, 1024, 1024, 1024, 0}; SO S; S.init(MX, 1024, F.G, bid);
        pg8::EpiOut E{F.out, F.XC, F.out, F.XC, F.MOD + 2 * 9 * 3072 + 2048, F.norm_g + 3072, F.MOD + 3 * 9 * 3072 + 1024, F.XT, F.SSQ};
        pg8::gemm_phase<pg8::EpiOut, SO>(F.lds, g, S, E); } SEAM(11);

    POOL_LAYER(12, 3, 1, MX)
    if (IN(15)) { pg8::Gemm g{A3, F.WPOUT + (size_t)1024 * 1024, MX, 1024, 1024, 1024, 1024, 0}; SO S; S.init(MX, 1024, F.G, bid);
        pg8::EpiOut E{F.out, F.XC, F.out, F.XC, F.MOD + 3 * 9 * 3072 + 2048, nullptr, nullptr, F.XT, F.SSQ};
        pg8::gemm_phase<pg8::EpiOut, SO>(F.lds, g, S, E); } SEAM(15);
    if (IN(16)) { e_final(F); }
#undef IN
#undef SEAM
}

extern "C" void kernel_launch(void* const* d_in, const int* in_sizes, int n_in, void* d_out, int out_size, void* d_ws, size_t ws_size, hipStream_t stream) {
    static int grid = 0;
    if (grid == 0) {
        if (n_in != 19 || out_size != MX * DM || ws_size < WS_END) { fprintf(stderr, "kernel_launch: unexpected shapes (n_in %d, out %d, ws %zu); nothing launched\n", n_in, out_size, ws_size); grid = -1; return; }
        int dev = 0, cus = 0, per_cu = 0;
        if (hipGetDevice(&dev) != hipSuccess || hipDeviceGetAttribute(&cus, hipDeviceAttributeMultiprocessorCount, dev) != hipSuccess) { grid = -1; return; }
        if (hipFuncSetAttribute((const void*)fwd_mega, hipFuncAttributeMaxDynamicSharedMemorySize, LDS_BYTES) != hipSuccess) { fprintf(stderr, "kernel_launch: hipFuncSetAttribute failed\n"); grid = -1; return; }
        if (hipOccupancyMaxActiveBlocksPerMultiprocessor(&per_cu, (const void*)fwd_mega, NWAVES * 64, LDS_BYTES) != hipSuccess || per_cu < 1) { fprintf(stderr, "kernel_launch: occupancy query reports %d workgroups per CU\n", per_cu); (void)hipGetLastError(); grid = -1; return; }
        grid = cus;
    }
    if (grid < 0) return;
    (void)hipMemsetAsync((char*)d_ws + WS_CTL, 0, CTL_ZERO_BYTES, stream);
    Args a{};
    for (int i = 0; i < 19; ++i) a.in[i] = (const float*)d_in[i];
    a.out = (float*)d_out; a.ws = (unsigned char*)d_ws;
#if MK_PER_PHASE
    for (int p = 0; p < NPHASE; ++p) { a.ph_lo = p; a.ph_hi = p + 1; hipLaunchKernelGGL(fwd_mega, dim3(grid), dim3(NWAVES * 64), LDS_BYTES, stream, a); }
#else
    a.ph_lo = 0; a.ph_hi = NPHASE;
    hipLaunchKernelGGL(fwd_mega, dim3(grid), dim3(NWAVES * 64), LDS_BYTES, stream, a);
#endif
}
```

```cpp
#include <hip/hip_runtime.h>
#include <cstdio>
#include <cstdint>

#ifndef MK_PER_PHASE
#define MK_PER_PHASE 0
#endif
#ifndef MK_REP
#define MK_REP -1
#endif
#ifndef MK_NAIVE_ATTN
#define MK_NAIVE_ATTN 0
#endif

#define GAS __attribute__((address_space(1)))
#define LAS __attribute__((address_space(3)))
typedef unsigned short bf16_t;
typedef short bf16x8 __attribute__((ext_vector_type(8)));
typedef float f32x4 __attribute__((ext_vector_type(4)));
typedef unsigned u32x4 __attribute__((ext_vector_type(4)));
typedef unsigned u32x2 __attribute__((ext_vector_type(2)));
typedef float f32x2_t __attribute__((ext_vector_type(2)));
typedef __bf16 bf16x2_t __attribute__((ext_vector_type(2)));

constexpr int DM = 1024, NB = 8, SEQ = 2048, CTXL = 256;
constexpr int MX = NB * SEQ;
constexpr int MC = NB * CTXL;
constexpr int MT = MX + MC;
constexpr float EPS = 1e-6f;
constexpr float LOG2E = 1.4426950408889634f;
constexpr float QSCALE = 0.125f * LOG2E;

__device__ __forceinline__ unsigned cvtpk(float lo, float hi) { f32x2_t v = {lo, hi}; bf16x2_t b = __builtin_convertvector(v, bf16x2_t); return __builtin_bit_cast(unsigned, b); }
__device__ __forceinline__ float bflo(unsigned u) { return __builtin_bit_cast(float, u << 16); }
__device__ __forceinline__ float bfhi(unsigned u) { return __builtin_bit_cast(float, u & 0xffff0000u); }
__device__ __forceinline__ float silu_f(float v) { return v * __builtin_amdgcn_rcpf(1.0f + __builtin_amdgcn_exp2f(-LOG2E * v)); }
__device__ __forceinline__ float wave_sum(float v) {
#pragma unroll
    for (int o = 1; o < 64; o <<= 1) v += __shfl_xor(v, o);
    return v;
}
__device__ __forceinline__ float wave_max(float v) {
#pragma unroll
    for (int o = 1; o < 64; o <<= 1) v = fmaxf(v, __shfl_xor(v, o));
    return v;
}

namespace pg8 {
#define PG8_LAS __attribute__((address_space(3)))
constexpr int BM = 256, BK = 64, HALF = 128, HTB = HALF * BK * 2, STAGE_BYTES = 8 * HTB, NXCD = 8, WGM = 8;

__host__ __device__ __forceinline__ int lds_byte(int r, int c) { const int st = (r >> 4) * 2 + (c >> 5), rr = r & 15, cc = c & 31, ob = rr * 64 + cc * 2; return st * 1024 + (ob ^ (((ob >> 9) & 1) << 5)); }
__host__ __device__ __forceinline__ void stage_rc(int b, int& R, int& C) { const int st = b / 1024, sb = b % 1024, swz = sb ^ (((sb >> 9) & 1) << 5); R = (st >> 1) * 16 + swz / 64; C = (st & 1) * 32 + (swz % 64) / 2; }
__host__ __device__ __forceinline__ int perm32(int rho) { const int n = rho >> 4, i = rho & 15; return 8 * (i >> 2) + 4 * n + (i & 3); }

struct Unit { int pm, pn; };
struct Gemm { const bf16_t* A; const bf16_t* Bt; int M, N, K, lda, ldb, acol; };

struct StaticOrder {
    int nM, nN, nwg, G, c;
    __host__ __device__ void init(int M, int N, int G_, int c_) { nM = M / BM; nN = N / BM; nwg = nM * nN; G = G_; c = c_; }
    __host__ __device__ bool next(int i, Unit& u) const {
        const long L = (long)i * G + c; if (L >= nwg) return false;
        int wgid = (int)L; { const int q = nwg / NXCD, r = nwg % NXCD, xcd = wgid % NXCD, off = wgid / NXCD; wgid = (xcd < r ? xcd * (q + 1) : r * (q + 1) + (xcd - r) * q) + off; }
        const int nig = WGM * nN, gid = wgid / nig, fm = gid * WGM, gsz = (nM - fm) < WGM ? (nM - fm) : WGM;
        u.pm = fm + ((wgid % nig) % gsz); u.pn = (wgid % nig) / gsz; return true;
    }
};

template <class Epi, class Sched, bool ALIGN_EPI = true>
__device__ __forceinline__ void gemm_phase(PG8_LAS unsigned char* lds, const Gemm g, const Sched& S, const Epi& E) {
    const int tid = threadIdx.x, wid = __builtin_amdgcn_readfirstlane(tid >> 6), lane = tid & 63, wr = wid >> 2, wc = wid & 3, fr = lane & 15, fq = lane >> 4;
    const int K = g.K, nt = K / BK;
    unsigned voffA[2], voffB[2];
#pragma unroll
    for (int i = 0; i < 2; ++i) { int R, C; stage_rc(tid * 16 + i * 8192, R, C); const int Rb = Epi::PERM ? ((R & ~31) + perm32(R & 31)) : R;
        voffA[i] = (unsigned)(R * g.lda + C) * 2u; voffB[i] = (unsigned)(Rb * g.ldb + C) * 2u; }
    const size_t kstep = (size_t)(BK * 2);
    const size_t hstepA = (size_t)HALF * g.lda * 2, hstepB = (size_t)HALF * g.ldb * 2;
    const size_t tstepA = 2 * hstepA, tstepB = 2 * hstepB;
    const unsigned ldsw = (unsigned)wid * 1024u;
    const int aoff = lds_byte(wr * 64 + fr, fq * 8), boff = lds_byte(wc * 32 + fr, fq * 8);
#define PG8_SA(b, h) (((b) * 2 + (h)) * HTB)
#define PG8_SB(b, h) ((4 + (b) * 2 + (h)) * HTB)
#define PG8_STAGE(bufoff, gbase, voff) do { _Pragma("unroll") for (int _i = 0; _i < 2; ++_i) \
        __builtin_amdgcn_global_load_lds((const unsigned*)((const char*)(gbase) + (voff)[_i]), (PG8_LAS unsigned*)(lds + (bufoff) + ldsw + _i * 8192), 16, 0, 0); } while (0)
#define PG8_LDA(dst, b, h) do { _Pragma("unroll") for (int m = 0; m < 4; ++m) _Pragma("unroll") for (int k = 0; k < 2; ++k) dst[m][k] = *(const PG8_LAS bf16x8*)(lds + PG8_SA(b, h) + aoff + m * 2048 + k * 1024); } while (0)
#define PG8_LDB(dst, b, h) do { _Pragma("unroll") for (int n = 0; n < 2; ++n) _Pragma("unroll") for (int k = 0; k < 2; ++k) dst[n][k] = *(const PG8_LAS bf16x8*)(lds + PG8_SB(b, h) + boff + n * 2048 + k * 1024); } while (0)
#define PG8_MMA(ai, bj, At, Bt) do { __builtin_amdgcn_s_setprio(1); _Pragma("unroll") for (int m = 0; m < 4; ++m) _Pragma("unroll") for (int n = 0; n < 2; ++n) _Pragma("unroll") for (int k = 0; k < 2; ++k) \
        acc[ai][bj][m][n] = __builtin_amdgcn_mfma_f32_16x16x32_bf16(Bt[n][k], At[m][k], acc[ai][bj][m][n], 0, 0, 0); __builtin_amdgcn_s_setprio(0); } while (0)
#define PG8_WAIT_V(n) asm volatile("s_waitcnt vmcnt(" #n ")" ::: "memory")
#define PG8_WAIT_L(n) asm volatile("s_waitcnt lgkmcnt(" #n ")" ::: "memory")
#define PG8_BAR __builtin_amdgcn_s_barrier()
#define PG8_SCHED __builtin_amdgcn_sched_barrier(0)
    Unit cur, nxt; int ui = 0;
    if (!S.next(0, cur)) return;
    f32x4 acc[2][2][4][2];
#pragma unroll
    for (int a = 0; a < 2; ++a)
#pragma unroll
        for (int b = 0; b < 2; ++b)
#pragma unroll
            for (int m = 0; m < 4; ++m)
#pragma unroll
                for (int n = 0; n < 2; ++n) acc[a][b][m][n] = (f32x4){0.f, 0.f, 0.f, 0.f};
    bf16x8 At[4][2], B0[2][2], B1[2][2];
    const char* cA = (const char*)g.A + (size_t)cur.pm * tstepA + (size_t)cur.pn * g.acol * 2; const char* cB = (const char*)g.Bt + (size_t)cur.pn * tstepB;
    PG8_STAGE(PG8_SB(0, 0), cB, voffB); PG8_STAGE(PG8_SB(0, 1), cB + hstepB, voffB); PG8_STAGE(PG8_SA(0, 0), cA, voffA); PG8_STAGE(PG8_SA(0, 1), cA + hstepA, voffA);
    if (wr == 1) PG8_BAR;
    PG8_WAIT_V(2); PG8_BAR;
    PG8_STAGE(PG8_SB(1, 0), cB + kstep, voffB); PG8_STAGE(PG8_SA(1, 0), cA + kstep, voffA); PG8_STAGE(PG8_SB(1, 1), cB + hstepB + kstep, voffB);
    PG8_WAIT_V(6); PG8_BAR;
    for (;;) {
        const bool has_next = S.next(ui + 1, nxt);
        const char* nA = has_next ? (const char*)g.A + (size_t)nxt.pm * tstepA + (size_t)nxt.pn * g.acol * 2 : cA; const char* nB = has_next ? (const char*)g.Bt + (size_t)nxt.pn * tstepB : cB;
        for (int t = 0; t < nt; t += 2) {
            const bool last = (t == nt - 2);
            const char* a1 = cA + (size_t)(t + 1) * kstep;
            const char* a2 = last ? nA : cA + (size_t)(t + 2) * kstep; const char* b2 = last ? nB : cB + (size_t)(t + 2) * kstep;
            const char* a3 = a2 + kstep; const char* b3 = b2 + kstep;
            PG8_LDB(B0, 0, 0); PG8_LDB(B1, 0, 1); PG8_SCHED; PG8_LDA(At, 0, 0); PG8_STAGE(PG8_SA(1, 1), a1 + hstepA, voffA);
            PG8_WAIT_V(8); PG8_WAIT_L(0); PG8_BAR; PG8_MMA(0, 0, At, B0); PG8_MMA(0, 1, At, B1); PG8_BAR; PG8_SCHED;
            PG8_LDA(At, 0, 1); PG8_STAGE(PG8_SB(0, 0), b2, voffB); PG8_STAGE(PG8_SB(0, 1), b2 + hstepB, voffB); PG8_STAGE(PG8_SA(0, 0), a2, voffA);
            PG8_WAIT_V(8); PG8_WAIT_L(0); PG8_BAR; PG8_MMA(1, 0, At, B0); PG8_MMA(1, 1, At, B1); PG8_BAR; PG8_SCHED;
            PG8_LDB(B0, 1, 0); PG8_LDB(B1, 1, 1); PG8_SCHED; PG8_LDA(At, 1, 0); PG8_STAGE(PG8_SA(0, 1), a2 + hstepA, voffA);
            PG8_WAIT_V(8); PG8_WAIT_L(0); PG8_BAR; PG8_MMA(0, 0, At, B0); PG8_MMA(0, 1, At, B1); PG8_BAR; PG8_SCHED;
            PG8_LDA(At, 1, 1); PG8_STAGE(PG8_SB(1, 0), b3, voffB); PG8_STAGE(PG8_SB(1, 1), b3 + hstepB, voffB); PG8_STAGE(PG8_SA(1, 0), a3, voffA);
            PG8_WAIT_V(8); PG8_WAIT_L(0); PG8_BAR; PG8_MMA(1, 0, At, B0); PG8_MMA(1, 1, At, B1); PG8_BAR; PG8_SCHED;
        }
        if constexpr (ALIGN_EPI) { if (wr == 0) PG8_BAR; }
        E(acc, cur, wr, wc, fr, fq);
        if (!has_next) break;
#pragma unroll
        for (int a = 0; a < 2; ++a)
#pragma unroll
            for (int b = 0; b < 2; ++b)
#pragma unroll
                for (int m = 0; m < 4; ++m)
#pragma unroll
                    for (int n = 0; n < 2; ++n) acc[a][b][m][n] = (f32x4){0.f, 0.f, 0.f, 0.f};
        cur = nxt; cA = nA; cB = nB; ++ui;
        if constexpr (ALIGN_EPI) { if (wr == 1) PG8_BAR; }
    }
    PG8_WAIT_V(0);
    if constexpr (!ALIGN_EPI) { if (wr == 0) PG8_BAR; }
    PG8_BAR;
#undef PG8_SA
#undef PG8_SB
#undef PG8_STAGE
#undef PG8_LDA
#undef PG8_LDB
#undef PG8_MMA
#undef PG8_WAIT_V
#undef PG8_WAIT_L
#undef PG8_BAR
#undef PG8_SCHED
}

__device__ __forceinline__ float row_rstd(const float* ssq, int row) {
    const f32x4* p = (const f32x4*)(ssq + (size_t)row * 16);
    const f32x4 a = p[0], b = p[1], c = p[2], d = p[3];
    const float s = ((a.x + a.y) + (a.z + a.w)) + ((b.x + b.y) + (b.z + b.w)) + ((c.x + c.y) + (c.z + c.w)) + ((d.x + d.y) + (d.z + d.w));
    return rsqrtf(s * (1.0f / 1024.0f) + EPS);
}

__device__ __forceinline__ void rows_rstd(const float* ssq, int rowbase, int fq, float (&rs)[8]) {
    f32x4 q[8];
#pragma unroll
    for (int g = 0; g < 8; ++g) q[g] = *(const f32x4*)(ssq + (size_t)(rowbase + (g >> 2) * 128 + (g & 3) * 16) * 16 + fq * 4);
#pragma unroll
    for (int g = 0; g < 8; ++g) { float t = (q[g].x + q[g].y) + (q[g].z + q[g].w); t += __shfl_xor(t, 16); t += __shfl_xor(t, 32); rs[g] = rsqrtf(t * (1.0f / 1024.0f) + EPS); }
}
__device__ __forceinline__ u32x4 pack8(const f32x4 v0, const f32x4 v1) { u32x4 w; w.x = cvtpk(v0[0], v0[1]); w.y = cvtpk(v0[2], v0[3]); w.z = cvtpk(v1[0], v1[1]); w.w = cvtpk(v1[2], v1[3]); return w; }

struct EpiPool1 {
    static constexpr bool PERM = true;
    const float* ssq; const float* cvec; const float* pscale; bf16_t* U; bf16_t* SG;
    __device__ __forceinline__ void operator()(const f32x4 (&acc)[2][2][4][2], const Unit& u, int wr, int wc, int fr, int fq) const {
        const int bm = u.pm < 64 ? (u.pm >> 3) : 8;
        const bool isg = u.pn >= 4;
        const int ct = u.pn * 256 + wc * 32 + 8 * fq, co = (u.pn & 3) * 256 + wc * 32 + 8 * fq;
        f32x4 cv[2][2], sc[2][2];
#pragma unroll
        for (int bj = 0; bj < 2; ++bj)
#pragma unroll
            for (int n = 0; n < 2; ++n) { cv[bj][n] = *(const f32x4*)(cvec + (size_t)bm * 4096 + ct + bj * 128 + 4 * n);
                sc[bj][n] = isg ? *(const f32x4*)(pscale + co + bj * 128 + 4 * n) : (f32x4){1.f, 1.f, 1.f, 1.f}; }
        bf16_t* O = isg ? SG : U;
        float rsv[8]; rows_rstd(ssq, u.pm * 256 + wr * 64 + fr, fq, rsv);
#pragma unroll
        for (int ai = 0; ai < 2; ++ai)
#pragma unroll
            for (int m = 0; m < 4; ++m) { const int row = u.pm * 256 + ai * 128 + wr * 64 + m * 16 + fr; const float rs = rsv[ai * 4 + m];
#pragma unroll
                for (int bj = 0; bj < 2; ++bj) { f32x4 v0 = acc[ai][bj][m][0] * rs + cv[bj][0], v1 = acc[ai][bj][m][1] * rs + cv[bj][1];
                    if (isg) {
#pragma unroll
                        for (int j = 0; j < 4; ++j) { v0[j] = sc[bj][0][j] * silu_f(v0[j]); v1[j] = sc[bj][1][j] * silu_f(v1[j]); } }
                    *(u32x4*)(O + (size_t)row * 1024 + co + bj * 128) = pack8(v0, v1); }
                if (m & 1) asm volatile("" ::: "memory"); }
    }
};
struct EpiPool2 {
    static constexpr bool PERM = true;
    const bf16_t* SG; bf16_t* Z;
    __device__ __forceinline__ void operator()(const f32x4 (&acc)[2][2][4][2], const Unit& u, int wr, int wc, int fr, int fq) const {
        const int co = u.pn * 256 + wc * 32 + 8 * fq;
#pragma unroll
        for (int ai = 0; ai < 2; ++ai)
#pragma unroll
            for (int m = 0; m < 4; ++m) { const int row = u.pm * 256 + ai * 128 + wr * 64 + m * 16 + fr;
#pragma unroll
                for (int bj = 0; bj < 2; ++bj) { const u32x4 s = *(const u32x4*)(SG + (size_t)row * 1024 + co + bj * 128);
                    f32x4 v0 = acc[ai][bj][m][0], v1 = acc[ai][bj][m][1];
                    v0[0] *= bflo(s.x); v0[1] *= bfhi(s.x); v0[2] *= bflo(s.y); v0[3] *= bfhi(s.y);
                    v1[0] *= bflo(s.z); v1[1] *= bfhi(s.z); v1[2] *= bflo(s.w); v1[3] *= bfhi(s.w);
                    *(u32x4*)(Z + (size_t)row * 1024 + co + bj * 128) = pack8(v0, v1); }
                if (m & 1) asm volatile("" ::: "memory"); }
    }
};
struct EpiNa1 {
    static constexpr bool PERM = true;
    const float* ssq; const float* cvec; bf16_t* out; size_t tstride; int tbase; int bmfix;
    __device__ __forceinline__ void operator()(const f32x4 (&acc)[2][2][4][2], const Unit& u, int wr, int wc, int fr, int fq) const {
        const int bm = bmfix >= 0 ? bmfix : (u.pm >> 3);
        const int t = tbase + (u.pn >> 2);
        const int ct = u.pn * 256 + wc * 32 + 8 * fq, co = (u.pn & 3) * 256 + wc * 32 + 8 * fq;
        f32x4 cv[2][2];
#pragma unroll
        for (int bj = 0; bj < 2; ++bj)
#pragma unroll
            for (int n = 0; n < 2; ++n) cv[bj][n] = *(const f32x4*)(cvec + (size_t)bm * 4096 + ct + bj * 128 + 4 * n);
        bf16_t* O = out + (size_t)t * tstride;
        float rsv[8]; rows_rstd(ssq, u.pm * 256 + wr * 64 + fr, fq, rsv);
#pragma unroll
        for (int ai = 0; ai < 2; ++ai)
#pragma unroll
            for (int m = 0; m < 4; ++m) { const int row = u.pm * 256 + ai * 128 + wr * 64 + m * 16 + fr; const float rs = rsv[ai * 4 + m];
#pragma unroll
                for (int bj = 0; bj < 2; ++bj) { f32x4 v0 = acc[ai][bj][m][0] * rs + cv[bj][0], v1 = acc[ai][bj][m][1] * rs + cv[bj][1];
                    if (t == 0) { v0 = v0 * QSCALE; v1 = v1 * QSCALE; }
                    if (t == 3) {
#pragma unroll
                        for (int j = 0; j < 4; ++j) { v0[j] = silu_f(v0[j]); v1[j] = silu_f(v1[j]); } }
                    *(u32x4*)(O + (size_t)row * 1024 + co + bj * 128) = pack8(v0, v1); }
                if (m & 1) asm volatile("" ::: "memory"); }
    }
};
struct EpiConv1 {
    static constexpr bool PERM = true;
    const float* ssq; const float* cvec; bf16_t* P; bf16_t* S;
    __device__ __forceinline__ void operator()(const f32x4 (&acc)[2][2][4][2], const Unit& u, int wr, int wc, int fr, int fq) const {
        const int bm = u.pm >> 3;
        const int ct = u.pn * 256 + wc * 32 + 8 * fq, ch0 = u.pn * 64 + wc * 16 + 4 * fq;
        f32x4 cv[2][2];
#pragma unroll
        for (int bj = 0; bj < 2; ++bj)
#pragma unroll
            for (int n = 0; n < 2; ++n) cv[bj][n] = *(const f32x4*)(cvec + (size_t)bm * 4096 + ct + bj * 128 + 4 * n);
        float rsv[8]; rows_rstd(ssq, u.pm * 256 + wr * 64 + fr, fq, rsv);
#pragma unroll
        for (int ai = 0; ai < 2; ++ai)
#pragma unroll
            for (int m = 0; m < 4; ++m) { const int row = u.pm * 256 + ai * 128 + wr * 64 + m * 16 + fr; const float rs = rsv[ai * 4 + m];
                const f32x4 bg = acc[ai][0][m][0] * rs + cv[0][0], cg = acc[ai][0][m][1] * rs + cv[0][1], vv = acc[ai][1][m][0] * rs + cv[1][0], gg = acc[ai][1][m][1] * rs + cv[1][1];
                f32x4 p = cg * vv, s;
#pragma unroll
                for (int j = 0; j < 4; ++j) s[j] = bg[j] * silu_f(gg[j]);
                u32x2 pw, sw; pw.x = cvtpk(p[0], p[1]); pw.y = cvtpk(p[2], p[3]); sw.x = cvtpk(s[0], s[1]); sw.y = cvtpk(s[2], s[3]);
                *(u32x2*)(P + (size_t)row * 1024 + ch0) = pw; *(u32x2*)(S + (size_t)row * 1024 + ch0) = sw;
                if (m & 1) asm volatile("" ::: "memory"); }
    }
};
struct EpiOut {
    static constexpr bool PERM = false;
    const float* basex; const float* basec; float* outx; float* outc;
    const float* gate;
    const float* gnext;
    const float* scnext;
    bf16_t* XT; float* ssq;
    __device__ __forceinline__ void operator()(const f32x4 (&acc)[2][2][4][2], const Unit& u, int wr, int wc, int fr, int fq) const {
        const bool isc = u.pm >= 64; const int bm = isc ? 8 : (u.pm >> 3);
        const int col0 = u.pn * 256 + wc * 32 + 4 * fq;
        f32x4 gt[2][2], an[2][2];
#pragma unroll
        for (int bj = 0; bj < 2; ++bj)
#pragma unroll
            for (int n = 0; n < 2; ++n) { gt[bj][n] = *(const f32x4*)(gate + (size_t)bm * 3072 + col0 + bj * 128 + n * 16);
                if (gnext) an[bj][n] = *(const f32x4*)(gnext + col0 + bj * 128 + n * 16) * (*(const f32x4*)(scnext + (size_t)bm * 3072 + col0 + bj * 128 + n * 16) + 1.0f);
                else an[bj][n] = (f32x4){0.f, 0.f, 0.f, 0.f}; }
        const float* bp = isc ? basec - (size_t)MX * 1024 : basex; float* op = isc ? outc - (size_t)MX * 1024 : outx;
        const size_t off0 = (size_t)(u.pm * 256 + wr * 64 + fr) * 1024 + col0;
        f32x4 xin[3][2][2];
#define EO_OFF(g) (off0 + (size_t)(((g) >> 2) * 128 + ((g) & 3) * 16) * 1024)
#define EO_LOAD(g) do { _Pragma("unroll") for (int bj = 0; bj < 2; ++bj) _Pragma("unroll") for (int n = 0; n < 2; ++n) xin[(g) % 3][bj][n] = *(const f32x4*)(bp + EO_OFF(g) + bj * 128 + n * 16); } while (0)
        EO_LOAD(0); EO_LOAD(1);
#pragma unroll
        for (int g = 0; g < 8; ++g) { const int ai = g >> 2, m = g & 3; const size_t off = EO_OFF(g); float s = 0.f;
            if (g + 2 < 8) EO_LOAD(g + 2);
#pragma unroll
            for (int bj = 0; bj < 2; ++bj)
#pragma unroll
                for (int n = 0; n < 2; ++n) { const f32x4 y = xin[g % 3][bj][n] + gt[bj][n] * acc[ai][bj][m][n];
                    *(f32x4*)(op + off + bj * 128 + n * 16) = y; s += (y[0] * y[0] + y[1] * y[1]) + (y[2] * y[2] + y[3] * y[3]);
                    if (gnext) { const f32x4 tt = y * an[bj][n]; u32x2 w; w.x = cvtpk(tt[0], tt[1]); w.y = cvtpk(tt[2], tt[3]); *(u32x2*)(XT + off + bj * 128 + n * 16) = w; } }
            s += __shfl_xor(s, 16); s += __shfl_xor(s, 32);
            if (fq == 0) ssq[(size_t)(u.pm * 256 + wr * 64 + fr + ai * 128 + m * 16) * 16 + u.pn * 4 + wc] = s;
            asm volatile("" ::: "memory"); }
#undef EO_LOAD
#undef EO_OFF
    }
};
}

constexpr size_t MiB = 1u << 20;
constexpr size_t WS_CTL = 0, CTL_ZERO_BYTES = 1 * MiB;
constexpr size_t WS_MOD = 1 * MiB;
constexpr size_t WS_CVEC = 2 * MiB;
constexpr size_t WS_SSQ = 3 * MiB;
constexpr size_t WS_WPIN = 6 * MiB;
constexpr size_t WS_WGRP = 14 * MiB;
constexpr size_t WS_WPOUT = 15 * MiB;
constexpr size_t WS_WNIN = 19 * MiB;
constexpr size_t WS_WNOUT = 27 * MiB;
constexpr size_t WS_WCIN = 29 * MiB;
constexpr size_t WS_WCOUT = 37 * MiB;
constexpr size_t WS_XC = 40 * MiB;
constexpr size_t WS_XT = 48 * MiB;
constexpr size_t WS_ACT0 = 84 * MiB, ACT_STRIDE = 36 * MiB;
constexpr size_t WS_END = 228 * MiB;
constexpr int CW_BAR = 4096;

#define XB_TMO      128
#define XB_XCNT(j)  (256  + 64 * (j))
#define XB_XSUB(j)  (1280 + 64 * (j))
#define XB_XGEN(j)  (2304 + 64 * (j))
#define XB_TOP      3328
#define XB_TOPGEN   3392
#define XCD_BAR_WORDS 3456
#define XB_SPIN_CAP (1u << 18)
__device__ __forceinline__ unsigned xb_ld(unsigned* p)              { return __hip_atomic_load(p, __ATOMIC_RELAXED, __HIP_MEMORY_SCOPE_AGENT); }
__device__ __forceinline__ unsigned xb_add(unsigned* p, unsigned v) { return __hip_atomic_fetch_add(p, v, __ATOMIC_RELAXED, __HIP_MEMORY_SCOPE_AGENT); }
__device__ __forceinline__ unsigned xb_xcc_id() { return (unsigned)__builtin_amdgcn_s_getreg((3 << 11) | 20) & 0xFu; }
#define XB_SPIN(cond, bar) do { unsigned _sp = 0; while (cond) { __builtin_amdgcn_s_sleep(1); \
    if ((++_sp & 255u) == 0u) { if (xb_ld(&(bar)[XB_TMO])) break; if (_sp > XB_SPIN_CAP) { atomicAdd(&(bar)[XB_TMO], 1u); break; } } } } while (0)
struct XcdBarrier { unsigned* bar; unsigned x; volatile LAS unsigned* st; };
__device__ __forceinline__ XcdBarrier xcd_barrier_post(unsigned* bar, volatile LAS unsigned* st) {
    XcdBarrier b; b.bar = bar; b.x = xb_xcc_id(); b.st = st;
    if (threadIdx.x == 0) (void)xb_add(&bar[XB_XCNT(b.x)], 1u);
    return b;
}
__device__ __forceinline__ void xcd_barrier_complete(unsigned* bar, unsigned x, unsigned& nloc, unsigned& nx) {
    const unsigned G = gridDim.x * gridDim.y * gridDim.z;
    unsigned sum, cnt, mine, sp = 0u;
    for (;;) {
        sum = 0u; cnt = 0u; mine = 0u;
#pragma unroll
        for (unsigned j = 0; j < 16; ++j) { const unsigned c = xb_ld(&bar[XB_XCNT(j)]); sum += c; cnt += (c > 0u) ? 1u : 0u; mine = (j == x) ? c : mine; }
        if (sum == G) break;
        __builtin_amdgcn_s_sleep(1);
        if ((++sp & 255u) == 0u) { if (xb_ld(&bar[XB_TMO])) break; if (sp > XB_SPIN_CAP) { atomicAdd(&bar[XB_TMO], 1u); break; } }
    }
    nloc = mine > 0u ? mine : 1u; nx = cnt > 0u ? cnt : 1u;
}
__device__ __forceinline__ void xcd_barrier(const XcdBarrier& b) {
    asm volatile("s_waitcnt vmcnt(0)" ::: "memory");
    __syncthreads();
    if (threadIdx.x == 0) {
        unsigned* bar = b.bar;
        __builtin_amdgcn_s_waitcnt(0);
        unsigned nloc = b.st[0], nx = b.st[1];
        if (nloc == 0u) { xcd_barrier_complete(bar, b.x, nloc, nx); b.st[0] = nloc; b.st[1] = nx; }
        const unsigned old = xb_add(&bar[XB_XSUB(b.x)], 1u);
        const unsigned gen = old / nloc;
        if (old + 1u == (gen + 1u) * nloc) {
            __builtin_amdgcn_fence(__ATOMIC_RELEASE, "agent");
            asm volatile("s_waitcnt vmcnt(0)" ::: "memory");
            const unsigned og = xb_add(&bar[XB_TOP], 1u);
            const unsigned tg = og / nx;
            if (og + 1u == (tg + 1u) * nx) xb_add(&bar[XB_TOPGEN], 1u);
            else XB_SPIN(xb_ld(&bar[XB_TOPGEN]) == tg, bar);
            __builtin_amdgcn_fence(__ATOMIC_ACQUIRE, "agent");
            xb_add(&bar[XB_XGEN(b.x)], 1u);
            asm volatile("s_waitcnt vmcnt(0)" ::: "memory");
        } else {
            XB_SPIN(xb_ld(&bar[XB_XGEN(b.x)]) == gen, bar);
            __builtin_amdgcn_fence(__ATOMIC_ACQUIRE, "agent");
            asm volatile("s_waitcnt vmcnt(0)" ::: "memory");
        }
    }
    __syncthreads();
}

constexpr int NWAVES = 8;
constexpr int RING_BYTES = 131072, LDSCTL_OFF = RING_BYTES, MISC_OFF = LDSCTL_OFF + 320, LDS_BYTES = 147456;

struct Args { const float* in[19]; float* out; unsigned char* ws; int ph_lo, ph_hi; };

struct Frame {
    LAS unsigned char* lds; volatile LAS unsigned* MISC;
    int tid, lane, wave, vcu, G;
    const float *x, *c, *ctx, *c_ctx, *norm_g, *ada_w, *ada_b, *pool_w_in, *pool_w_grp, *pool_scale, *pool_w_out, *na_w_in, *na_rpb, *na_w_out, *conv_w_in, *conv_dw, *conv_db, *conv_w_out, *final_g;
    float* out; unsigned char* ws;
    float *MOD, *CVEC, *SSQ, *XC;
    bf16_t *WPIN, *WGRP, *WPOUT, *WNIN, *WNOUT, *WCIN, *WCOUT, *XT, *ACT0;
};

__device__ __forceinline__ void p0_mod_task(Frame& F, int task) {
    const int layer = task / 48, col0 = (task % 48) * 64;
    LAS float* sc = (LAS float*)F.lds;
    LAS float* red = sc + 9 * 1024;
    for (int i = F.tid; i < 9 * 1024; i += NWAVES * 64) { const int b = i >> 10, k = i & 1023; const float v = (b < 8) ? F.c[b * 1024 + k] : F.c_ctx[k]; sc[i] = silu_f(v); }
    __syncthreads();
    const float* W = F.ada_w + (size_t)layer * 1024 * 3072 + col0;
    const int kr = F.lane >> 4, cl = (F.lane & 15) * 4;
    float acc[9][4];
#pragma unroll
    for (int b = 0; b < 9; ++b)
#pragma unroll
        for (int j = 0; j < 4; ++j) acc[b][j] = 0.f;
    const int kbase = F.wave * 128;
#pragma unroll 4
    for (int it = 0; it < 32; ++it) { const int k = kbase + it * 4 + kr; const f32x4 w = *(const f32x4*)(W + (size_t)k * 3072 + cl);
#pragma unroll
        for (int b = 0; b < 9; ++b) { const float s = sc[b * 1024 + k];
#pragma unroll
            for (int j = 0; j < 4; ++j) acc[b][j] += s * w[j]; } }
#pragma unroll
    for (int b = 0; b < 9; ++b)
#pragma unroll
        for (int j = 0; j < 4; ++j) { float v = acc[b][j]; v += __shfl_xor(v, 16); v += __shfl_xor(v, 32); acc[b][j] = v; }
    if (kr == 0) {
#pragma unroll
        for (int b = 0; b < 9; ++b)
#pragma unroll
            for (int j = 0; j < 4; ++j) red[(F.wave * 9 + b) * 64 + cl + j] = acc[b][j]; }
    __syncthreads();
    for (int o = F.tid; o < 576; o += NWAVES * 64) { const int b = o >> 6, cc = o & 63; float s = 0.f;
#pragma unroll
        for (int w = 0; w < 8; ++w) s += red[(w * 9 + b) * 64 + cc];
        F.MOD[(size_t)(layer * 9 + b) * 3072 + col0 + cc] = s + F.ada_b[layer * 3072 + col0 + cc]; }
    __syncthreads();
}
__device__ __forceinline__ unsigned f2bf(float f) { unsigned u = __builtin_bit_cast(unsigned, f); return (u + 0x7fffu + ((u >> 16) & 1u)) >> 16; }
__device__ __forceinline__ unsigned pk2(float lo, float hi) { return f2bf(lo) | (f2bf(hi) << 16); }
__device__ __forceinline__ int conv_row(int n) { const int split = n >> 10, ch = n & 1023; return (ch >> 6) * 256 + (split >> 1) * 128 + ((ch >> 4) & 3) * 32 + ((ch >> 2) & 3) * 8 + (split & 1) * 4 + (ch & 3); }
template <int MODE>
__device__ __forceinline__ void p0_transpose_item(const float* W, int K, int N, bf16_t* WT, LAS float* scr, int item, int lane) {
    const int nblk = N / 32, kb = item / nblk, nb = item % nblk, k0 = 64 * kb, n0 = 32 * nb;
#pragma unroll 8
    for (int i = 0; i < 32; ++i) { const int kk = 2 * i + (lane >> 5); scr[kk * 33 + (lane & 31)] = W[(size_t)(k0 + kk) * N + n0 + (lane & 31)]; }
    asm volatile("s_waitcnt lgkmcnt(0)" ::: "memory");
    const int c = lane & 7;
#pragma unroll
    for (int j = 0; j < 4; ++j) { const int n = (lane >> 3) + 8 * j; const LAS float* s = scr + (8 * c) * 33 + n;
        u32x4 o; o.x = pk2(s[0 * 33], s[1 * 33]); o.y = pk2(s[2 * 33], s[3 * 33]); o.z = pk2(s[4 * 33], s[5 * 33]); o.w = pk2(s[6 * 33], s[7 * 33]);
        const int drow = MODE == 1 ? conv_row(n0 + n) : (n0 + n);
        *(u32x4*)(WT + (size_t)drow * K + k0 + 8 * c) = o; }
    asm volatile("s_waitcnt lgkmcnt(0)" ::: "memory");
}
__device__ __forceinline__ void p0_prologue(Frame& F) {
    for (int t = (int)blockIdx.x; t < 192; t += F.G) p0_mod_task(F, t);
    LAS float* scr = (LAS float*)(F.lds + F.wave * 16384);
    const int gw = F.vcu * NWAVES + F.wave, NGW = F.G * NWAVES;
    constexpr int I_PIN = 16 * 64, I_GRP = 4 * 8, I_SQ = 16 * 32, I_BIG = 16 * 128;
    constexpr int NITEMS = 2 * I_PIN + 8 * I_GRP + 2 * I_SQ + I_BIG + I_SQ + I_BIG + I_SQ;
    for (int it = gw; it < NITEMS; it += NGW) {
        int r = it;
        if (r < 2 * I_PIN) { const int j = r / I_PIN; p0_transpose_item<0>(F.pool_w_in + (size_t)j * 1024 * 2048, 1024, 2048, F.WPIN + (size_t)j * 2048 * 1024, scr, r % I_PIN, F.lane); continue; } r -= 2 * I_PIN;
        if (r < 8 * I_GRP) { const int j = r / I_GRP; p0_transpose_item<0>(F.pool_w_grp + (size_t)j * 65536, 256, 256, F.WGRP + (size_t)j * 65536, scr, r % I_GRP, F.lane); continue; } r -= 8 * I_GRP;
        if (r < 2 * I_SQ) { const int j = r / I_SQ; p0_transpose_item<0>(F.pool_w_out + (size_t)j * 1024 * 1024, 1024, 1024, F.WPOUT + (size_t)j * 1024 * 1024, scr, r % I_SQ, F.lane); continue; } r -= 2 * I_SQ;
        if (r < I_BIG) { p0_transpose_item<0>(F.na_w_in, 1024, 4096, F.WNIN, scr, r, F.lane); continue; } r -= I_BIG;
        if (r < I_SQ) { p0_transpose_item<0>(F.na_w_out, 1024, 1024, F.WNOUT, scr, r, F.lane); continue; } r -= I_SQ;
        if (r < I_BIG) { p0_transpose_item<1>(F.conv_w_in, 1024, 4096, F.WCIN, scr, r, F.lane); continue; } r -= I_BIG;
        p0_transpose_item<0>(F.conv_w_out, 1024, 1024, F.WCOUT, scr, r, F.lane);
    }
}
__device__ __forceinline__ void unpack8(const u32x4 w, float (&f)[8]) { f[0] = bflo(w.x); f[1] = bfhi(w.x); f[2] = bflo(w.y); f[3] = bfhi(w.y); f[4] = bflo(w.z); f[5] = bfhi(w.z); f[6] = bflo(w.w); f[7] = bfhi(w.w); }
__device__ __forceinline__ void p1_prep(Frame& F) {
    const int gw = F.vcu * NWAVES + F.wave, lane = F.lane;
    {
        LAS float* sh = (LAS float*)F.lds;
        int staged = -1;
        const int per = ((12288 + F.G - 1) / F.G + 7) & ~7;
        for (int st = 0; st < per / 8; ++st) {
            const int task0 = F.vcu * per + st * 8, task = task0 + F.wave;
            if (task0 >= 12288) break;
            const int L = task0 < 2048 ? 0 : task0 < 6144 ? 1 : task0 < 10240 ? 2 : 3;
            if (staged != L) { __syncthreads();
                for (int e = F.tid; e < 9 * 1024; e += NWAVES * 64) sh[e] = F.MOD[(size_t)(L * 9 + (e >> 10)) * 3072 + (e & 1023)];
                __syncthreads(); staged = L; }
            const int n = task - (L == 0 ? 0 : L == 1 ? 2048 : L == 2 ? 6144 : 10240);
            const bf16_t* WT = L == 0 ? F.WPIN : L == 1 ? F.WNIN : L == 2 ? F.WCIN : F.WPIN + (size_t)2048 * 1024;
            const u32x4 w0 = *(const u32x4*)(WT + (size_t)n * 1024 + lane * 8), w1 = *(const u32x4*)(WT + (size_t)n * 1024 + 512 + lane * 8);
            float wa[8], wb[8]; unpack8(w0, wa); unpack8(w1, wb);
            float d[9];
#pragma unroll
            for (int b = 0; b < 9; ++b) { const LAS f32x4* sp = (const LAS f32x4*)(sh + b * 1024 + lane * 8); const f32x4 s0 = sp[0], s1 = sp[1], s2 = sp[128], s3 = sp[129];
                float a = 0.f;
#pragma unroll
                for (int j = 0; j < 4; ++j) a += s0[j] * wa[j] + s1[j] * wa[4 + j] + s2[j] * wb[j] + s3[j] * wb[4 + j];
                d[b] = a; }
#pragma unroll
            for (int b = 0; b < 9; ++b) d[b] = wave_sum(d[b]);
            if (lane < 9) { float v = d[0];
#pragma unroll
                for (int b = 1; b < 9; ++b) v = lane == b ? d[b] : v;
                F.CVEC[(size_t)(L * 9 + lane) * 4096 + n] = v; }
        }
        __syncthreads();
    }
    {
        const int rpw = (MT + F.G * NWAVES - 1) / (F.G * NWAVES);
        const int rbeg = gw * rpw, rend = min(rbeg + rpw, MT);
        int bmc = -1; f32x4 a[4];
        for (int r = rbeg; r < rend; r += 3) {
            f32x4 v[3][4];
#pragma unroll
            for (int q = 0; q < 3; ++q) { const int row = min(r + q, MT - 1); const float* src = row < MX ? F.x + (size_t)row * 1024 : F.ctx + (size_t)(row - MX) * 1024;
#pragma unroll
                for (int j = 0; j < 4; ++j) v[q][j] = *(const f32x4*)(src + 256 * j + 4 * lane); }
#pragma unroll
            for (int q = 0; q < 3; ++q) { const int row = r + q; if (row < rend) {
                const int bm = row < MX ? (row >> 11) : 8;
                if (bm != bmc) { const float* scl = F.MOD + (size_t)bm * 3072 + 1024;
#pragma unroll
                    for (int j = 0; j < 4; ++j) a[j] = *(const f32x4*)(F.norm_g + 256 * j + 4 * lane) * (*(const f32x4*)(scl + 256 * j + 4 * lane) + 1.0f);
                    bmc = bm; }
                float ss = 0.f;
#pragma unroll
                for (int j = 0; j < 4; ++j) ss += (v[q][j].x * v[q][j].x + v[q][j].y * v[q][j].y) + (v[q][j].z * v[q][j].z + v[q][j].w * v[q][j].w);
                ss = wave_sum(ss);
                if (lane < 16) F.SSQ[(size_t)row * 16 + lane] = lane == 0 ? ss : 0.f;
#pragma unroll
                for (int j = 0; j < 4; ++j) { const f32x4 t = v[q][j] * a[j]; u32x2 w; w.x = cvtpk(t[0], t[1]); w.y = cvtpk(t[2], t[3]); *(u32x2*)(F.XT + (size_t)row * 1024 + 256 * j + 4 * lane) = w; } } }
        }
    }
}
__device__ __forceinline__ void e_pool(Frame& F, const bf16_t* U, bf16_t* A2, int nrows) {
    const int ntiles = (nrows / 32) * 2;
    const int lane = F.lane, wave = F.wave;
#define EP_GEOM(tile) const int ch_ = (tile) & 1, r0_ = ((tile) >> 1) * 32; \
        const int seq0_ = r0_ < MX ? (r0_ & ~(SEQ - 1)) : MX + ((r0_ - MX) & ~(CTXL - 1)); const int L_ = r0_ < MX ? SEQ : CTXL; const int t0_ = r0_ - seq0_;
#define EP_DMA(tile, bsel) do { EP_GEOM(tile) \
        _Pragma("unroll") for (int i_ = 0; i_ < 6; ++i_) { const int lr_ = wave + 8 * i_; const int t_ = min(max(t0_ - 8 + lr_, 0), L_ - 1); \
            __builtin_amdgcn_global_load_lds((const unsigned*)(U + (size_t)(seq0_ + t_) * 1024 + ch_ * 512 + lane * 8), (LAS unsigned*)(F.lds + (bsel) * 49152 + lr_ * 1024), 16, 0, 0); } } while (0)
    int tile = F.vcu, k = 0;
    if (tile < ntiles) EP_DMA(tile, 0);
    for (; tile < ntiles; tile += F.G, k ^= 1) {
        asm volatile("s_waitcnt vmcnt(0) lgkmcnt(0)" ::: "memory");
        __builtin_amdgcn_s_barrier();
        asm volatile("" ::: "memory");
        if (tile + F.G < ntiles) EP_DMA(tile + F.G, k ^ 1);
        EP_GEOM(tile)
        const int col = ch_ * 512 + lane * 8, hw = 1 << (col >> 8);
        const LAS unsigned char* img = F.lds + k * 49152 + lane * 16;
        const int tf = t0_ + 4 * wave;
        float S[8];
#pragma unroll
        for (int j = 0; j < 8; ++j) S[j] = 0.f;
        { const int lo = max(tf - hw, 0), hi = min(tf + hw, L_);
          for (int t = lo; t < hi; ++t) { float f[8]; unpack8(*(const LAS u32x4*)(img + (t - t0_ + 8) * 1024), f);
#pragma unroll
              for (int j = 0; j < 8; ++j) S[j] += f[j]; } }
#pragma unroll
        for (int i = 0; i < 4; ++i) { const int t = tf + i; const int lo = max(t - hw, 0), hi = min(t + hw, L_); const float inv = 1.0f / (float)(hi - lo);
            float f[8]; unpack8(*(const LAS u32x4*)(img + (t - t0_ + 8) * 1024), f);
            f32x4 o0, o1;
#pragma unroll
            for (int j = 0; j < 4; ++j) { o0[j] = S[j] * inv - f[j]; o1[j] = S[4 + j] * inv - f[4 + j]; }
            *(u32x4*)(A2 + (size_t)(seq0_ + t) * 1024 + col) = pg8::pack8(o0, o1);
            if (i < 3) {
                if (t + hw < L_) { float a[8]; unpack8(*(const LAS u32x4*)(img + (t + hw - t0_ + 8) * 1024), a);
#pragma unroll
                    for (int j = 0; j < 8; ++j) S[j] += a[j]; }
                if (t - hw >= 0) { float a[8]; unpack8(*(const LAS u32x4*)(img + (t - hw - t0_ + 8) * 1024), a);
#pragma unroll
                    for (int j = 0; j < 8; ++j) S[j] -= a[j]; } } }
    }
    asm volatile("s_waitcnt vmcnt(0) lgkmcnt(0)" ::: "memory");
    __builtin_amdgcn_s_barrier();
#undef EP_DMA
#undef EP_GEOM
}
__device__ __forceinline__ void e_conv(Frame& F, const bf16_t* P, const bf16_t* Sg, bf16_t* Z) {
    const int gt = F.vcu * (NWAVES * 64) + F.tid, NT = F.G * NWAVES * 64;
    const int nitems = (MX / 16) * 128;
    for (int id = gt; id < nitems; id += NT) {
        const int col = (id & 127) * 8, r0 = (id >> 7) * 16, t0 = r0 & (SEQ - 1);
        float w0[8], w1[8], w2[8], bb[8];
#pragma unroll
        for (int h = 0; h < 2; ++h) { const f32x4 a = *(const f32x4*)(F.conv_dw + col + 4 * h), b = *(const f32x4*)(F.conv_dw + 1024 + col + 4 * h), c = *(const f32x4*)(F.conv_dw + 2048 + col + 4 * h), d = *(const f32x4*)(F.conv_db + col + 4 * h);
#pragma unroll
            for (int j = 0; j < 4; ++j) { w0[4 * h + j] = a[j]; w1[4 * h + j] = b[j]; w2[4 * h + j] = c[j]; bb[4 * h + j] = d[j]; } }
        float prev[8], cur[8], nxt[8];
        if (t0 > 0) unpack8(*(const u32x4*)(P + (size_t)(r0 - 1) * 1024 + col), prev); else {
#pragma unroll
            for (int j = 0; j < 8; ++j) prev[j] = 0.f; }
        unpack8(*(const u32x4*)(P + (size_t)r0 * 1024 + col), cur);
        for (int i = 0; i < 16; ++i) { const int t = t0 + i;
            if (t + 1 < SEQ) unpack8(*(const u32x4*)(P + (size_t)(r0 + i + 1) * 1024 + col), nxt); else {
#pragma unroll
                for (int j = 0; j < 8; ++j) nxt[j] = 0.f; }
            float s[8]; unpack8(*(const u32x4*)(Sg + (size_t)(r0 + i) * 1024 + col), s);
            f32x4 o0, o1;
#pragma unroll
            for (int j = 0; j < 4; ++j) { o0[j] = s[j] * (w0[j] * prev[j] + w1[j] * cur[j] + w2[j] * nxt[j] + bb[j]); o1[j] = s[4 + j] * (w0[4 + j] * prev[4 + j] + w1[4 + j] * cur[4 + j] + w2[4 + j] * nxt[4 + j] + bb[4 + j]); }
            *(u32x4*)(Z + (size_t)(r0 + i) * 1024 + col) = pg8::pack8(o0, o1);
#pragma unroll
            for (int j = 0; j < 8; ++j) { prev[j] = cur[j]; cur[j] = nxt[j]; } }
    }
}
__device__ __forceinline__ void e_final(Frame& F) {
    const int gw = F.vcu * NWAVES + F.wave, NGW = F.G * NWAVES, lane = F.lane;
    for (int row = gw; row < MX; row += NGW) {
        const float rs = pg8::row_rstd(F.SSQ, row);
#pragma unroll
        for (int j = 0; j < 4; ++j) { float* p = F.out + (size_t)row * 1024 + 256 * j + 4 * lane; const f32x4 v = *(const f32x4*)p; const f32x4 g = *(const f32x4*)(F.final_g + 256 * j + 4 * lane); *(f32x4*)p = v * rs * g; }
    }
}
__device__ __forceinline__ void attn_naive(Frame& F, const bf16_t* Q, const bf16_t* Kb, const bf16_t* Vb, const bf16_t* SGb, bf16_t* Z) {
    const int gw = F.vcu * NWAVES + F.wave, NGW = F.G * NWAVES, lane = F.lane;
    for (int task = gw; task < MX * 16; task += NGW) {
        const int tok = task >> 4, h = task & 15;
        const int b = tok >> 11, pos = tok & 2047, r = pos >> 6, col = pos & 63;
        const int rs = min(max(r - 4, 0), 24), cs = min(max(col - 8, 0), 48);
        const bf16_t* qp = Q + (size_t)tok * 1024 + h * 64;
        float s[6]; int kt[6];
#pragma unroll
        for (int t = 0; t < 6; ++t) {
            float bias = 0.f; int ktok;
            if (t < 2) { const int kk = lane + 64 * t, i = kk >> 4, jj = kk & 15; ktok = b * 2048 + (rs + i) * 64 + cs + jj;
                bias = F.na_rpb[(h * 15 + (rs + i - r + 7)) * 31 + (cs + jj - col + 15)] * LOG2E; }
            else { ktok = MX + b * 256 + lane + 64 * (t - 2); }
            kt[t] = ktok;
            const bf16_t* kp = Kb + (size_t)ktok * 1024 + h * 64; float d = 0.f;
#pragma unroll
            for (int d8 = 0; d8 < 8; ++d8) { float qf[8], kf[8]; unpack8(*(const u32x4*)(qp + d8 * 8), qf); unpack8(*(const u32x4*)(kp + d8 * 8), kf);
#pragma unroll
                for (int j = 0; j < 8; ++j) d += qf[j] * kf[j]; }
            s[t] = d + bias;
        }
        float m = s[0];
#pragma unroll
        for (int t = 1; t < 6; ++t) m = fmaxf(m, s[t]);
        m = wave_max(m);
        float l = 0.f;
#pragma unroll
        for (int t = 0; t < 6; ++t) { s[t] = __builtin_amdgcn_exp2f(s[t] - m); l += s[t]; }
        l = wave_sum(l);
        float o = 0.f;
#pragma unroll
        for (int t = 0; t < 6; ++t)
            for (int src = 0; src < 64; ++src) { const float pv = __shfl(s[t], src); const int ktok = __shfl(kt[t], src);
                const float v = bflo((unsigned)Vb[(size_t)ktok * 1024 + h * 64 + lane]); o += pv * v; }
        const float sg = bflo((unsigned)SGb[(size_t)tok * 1024 + h * 64 + lane]);
        const float z = o / l * sg;
        Z[(size_t)tok * 1024 + h * 64 + lane] = (bf16_t)(cvtpk(z, 0.f) & 0xffffu);
    }
}


namespace att {
using f32x16 = __attribute__((ext_vector_type(16))) float;
using s16x4 = __attribute__((ext_vector_type(4))) short;
typedef short v4i16_t __attribute__((ext_vector_type(4)));
typedef LAS const char* lds_cptr;
constexpr int L_K = 0, L_V = 16384, L_TAB = 32768, L_WS = 36864, L_OST = 40960;
constexpr float NEG = -1e30f;
constexpr float THR = 8.0f;
__device__ __forceinline__ int crow(int r, int hi) { return (r & 3) + 8 * (r >> 2) + 4 * hi; }
__device__ __forceinline__ s16x4 vtr(lds_cptr p) { return __builtin_bit_cast(s16x4, __builtin_amdgcn_ds_read_tr16_b64_v4i16((LAS v4i16_t*)p)); }
__device__ __forceinline__ float half_max(float m) { auto rr = __builtin_amdgcn_permlane32_swap(__float_as_uint(m), __float_as_uint(m), false, false); return fmaxf(__uint_as_float(rr[0]), __uint_as_float(rr[1])); }
__device__ __forceinline__ float half_sum(float m) { auto rr = __builtin_amdgcn_permlane32_swap(__float_as_uint(m), __float_as_uint(m), false, false); return __uint_as_float(rr[0]) + __uint_as_float(rr[1]); }

__device__ __forceinline__ void attn_unit(LAS unsigned char* lds, int b, int h, int r0, const bf16_t* Q, const bf16_t* Kb, const bf16_t* Vb, const bf16_t* SGb, bf16_t* Z, const float* rpb, int tid, int wid, int lane) {
    const int r32 = lane & 31, hi = lane >> 5;
    const int rq = r0 + (wid >> 1), colq = 32 * (wid & 1) + r32;
    const int rsw = min(max(rq - 4, 0), 24);
    const int kr_lo = min(max(r0 - 4, 0), 24), kr_hi = min(max(r0 + 3 - 4, 0), 24) + 7;
    const int NL = kr_hi - kr_lo + 1, NT = NL + 4;
    if (tid < 480) { const int row = tid >> 5, ci = tid & 31; ((LAS float*)(lds + L_TAB))[tid] = ci < 31 ? rpb[(h * 15 + row) * 31 + ci] * LOG2E : NEG; }
    unsigned boffp[8];
    { const int cs = min(max(colq - 8, 0), 48);
#pragma unroll
      for (int g = 0; g < 8; ++g) { unsigned pk = 0;
#pragma unroll
          for (int j = 0; j < 4; ++j) { const int r = (g & 3) * 4 + j; const int kc = crow(r, hi) + 32 * (g >> 2); const bool valid = (unsigned)(kc - cs) < 16u; const unsigned o = valid ? (unsigned)(kc - colq + 15) * 4u : 124u; pk |= o << (8 * j); }
          boffp[g] = pk; } }
    const size_t qtok = (size_t)b * SEQ + rq * 64 + colq;
    bf16x8 qr[4];
#pragma unroll
    for (int d0 = 0; d0 < 4; ++d0) qr[d0] = *(const bf16x8*)(Q + qtok * 1024 + h * 64 + d0 * 16 + hi * 8);
    const bf16_t* ksrc = Kb + (size_t)lane * 1024 + h * 64 + wid * 8;
    const bf16_t* vsrc = Vb + (size_t)(16 * (wid & 3) + (lane >> 2)) * 1024 + h * 64 + (wid >> 2) * 32 + (lane & 3) * 8;
#define ATT_TOK(t) ((t) < NL ? (size_t)b * SEQ + (size_t)(kr_lo + (t)) * 64 : (size_t)MX + (size_t)b * CTXL + (size_t)((t) - NL) * 64)
#define ATT_DMA(t) do { const size_t tk_ = ATT_TOK(t) * 1024; const int bo_ = ((t) & 1) * 8192; \
        __builtin_amdgcn_global_load_lds((const unsigned*)(ksrc + tk_), (LAS unsigned*)(lds + L_K + bo_ + wid * 1024), 16, 0, 0); \
        __builtin_amdgcn_global_load_lds((const unsigned*)(vsrc + tk_), (LAS unsigned*)(lds + L_V + bo_ + wid * 1024), 16, 0, 0); } while (0)
    ATT_DMA(0);
    f32x16 o0, o1;
#pragma unroll
    for (int r = 0; r < 16; ++r) { o0[r] = 0.f; o1[r] = 0.f; }
    float mref = NEG, lsum = 0.f;
    LAS float* wsf = (LAS float*)(lds + L_WS) + wid * 64;
    const lds_cptr kp0 = (lds_cptr)(lds + L_K) + hi * 1024 + r32 * 16;
    const lds_cptr vp0 = (lds_cptr)(lds + L_V) + ((lane >> 4) & 1) * 32 + (lane & 3) * 8 + (4 * hi + ((lane & 15) >> 2)) * 64;
    for (int t = 0; t < NT; ++t) {
        asm volatile("s_waitcnt vmcnt(0) lgkmcnt(0)" ::: "memory");
        __builtin_amdgcn_s_barrier();
        asm volatile("" ::: "memory");
        if (t + 1 < NT) ATT_DMA(t + 1);
        const bool local = t < NL; const int kr = kr_lo + t;
        const bool active = !local || (kr >= rsw && kr < rsw + 8);
        if (active) {
            const int bo = (t & 1) * 8192;
            f32x16 p0, p1;
#pragma unroll
            for (int r = 0; r < 16; ++r) { p0[r] = 0.f; p1[r] = 0.f; }
            { const lds_cptr kb = kp0 + bo;
#pragma unroll
              for (int d0 = 0; d0 < 4; ++d0) { const bf16x8 a0 = *(const LAS bf16x8*)(kb + d0 * 2048), a1 = *(const LAS bf16x8*)(kb + d0 * 2048 + 512);
                  p0 = __builtin_amdgcn_mfma_f32_32x32x16_bf16(a0, qr[d0], p0, 0, 0, 0); p1 = __builtin_amdgcn_mfma_f32_32x32x16_bf16(a1, qr[d0], p1, 0, 0, 0); } }
            if (local) { const lds_cptr tb = (lds_cptr)(lds + L_TAB) + (kr - rq + 7) * 128;
#pragma unroll
                for (int r = 0; r < 16; ++r) { p0[r] += *(const LAS float*)(tb + ((boffp[r >> 2] >> (8 * (r & 3))) & 0xffu)); p1[r] += *(const LAS float*)(tb + ((boffp[4 + (r >> 2)] >> (8 * (r & 3))) & 0xffu)); } }
            float mt = fmaxf(p0[0], p1[0]);
#pragma unroll
            for (int r = 1; r < 16; ++r) mt = fmaxf(mt, fmaxf(p0[r], p1[r]));
            mt = half_max(mt);
            if (__any(mt > mref + THR)) {
                const float mnew = fmaxf(mref, mt), alpha = __builtin_amdgcn_exp2f(mref - mnew);
                lsum *= alpha; mref = mnew;
                if (hi == 0) wsf[r32] = alpha;
                asm volatile("s_waitcnt lgkmcnt(0)" ::: "memory");
#pragma unroll
                for (int r = 0; r < 16; ++r) { const float f = wsf[crow(r, hi)]; o0[r] *= f; o1[r] *= f; }
            }
            float sacc = 0.f;
#pragma unroll
            for (int r = 0; r < 16; ++r) { p0[r] = __builtin_amdgcn_exp2f(p0[r] - mref); p1[r] = __builtin_amdgcn_exp2f(p1[r] - mref); sacc += p0[r] + p1[r]; }
            lsum += sacc;
            u32x4 pw0, pw1, pw2, pw3;
            pw0 = (u32x4){cvtpk(p0[0], p0[1]), cvtpk(p0[2], p0[3]), cvtpk(p0[4], p0[5]), cvtpk(p0[6], p0[7])};
            pw1 = (u32x4){cvtpk(p0[8], p0[9]), cvtpk(p0[10], p0[11]), cvtpk(p0[12], p0[13]), cvtpk(p0[14], p0[15])};
            pw2 = (u32x4){cvtpk(p1[0], p1[1]), cvtpk(p1[2], p1[3]), cvtpk(p1[4], p1[5]), cvtpk(p1[6], p1[7])};
            pw3 = (u32x4){cvtpk(p1[8], p1[9]), cvtpk(p1[10], p1[11]), cvtpk(p1[12], p1[13]), cvtpk(p1[14], p1[15])};
            const lds_cptr vp = vp0 + bo;
#define ATT_VF(i) ({ const s16x4 lo_ = vtr(vp + (((i) >> 2) * 4096 + ((i) & 3) * 1024)); const s16x4 hi_ = vtr(vp + (((i) >> 2) * 4096 + ((i) & 3) * 1024 + 512)); (bf16x8){lo_[0], lo_[1], lo_[2], lo_[3], hi_[0], hi_[1], hi_[2], hi_[3]}; })
            o0 = __builtin_amdgcn_mfma_f32_32x32x16_bf16(__builtin_bit_cast(bf16x8, pw0), ATT_VF(0), o0, 0, 0, 0);
            o1 = __builtin_amdgcn_mfma_f32_32x32x16_bf16(__builtin_bit_cast(bf16x8, pw0), ATT_VF(4), o1, 0, 0, 0);
            o0 = __builtin_amdgcn_mfma_f32_32x32x16_bf16(__builtin_bit_cast(bf16x8, pw1), ATT_VF(1), o0, 0, 0, 0);
            o1 = __builtin_amdgcn_mfma_f32_32x32x16_bf16(__builtin_bit_cast(bf16x8, pw1), ATT_VF(5), o1, 0, 0, 0);
            o0 = __builtin_amdgcn_mfma_f32_32x32x16_bf16(__builtin_bit_cast(bf16x8, pw2), ATT_VF(2), o0, 0, 0, 0);
            o1 = __builtin_amdgcn_mfma_f32_32x32x16_bf16(__builtin_bit_cast(bf16x8, pw2), ATT_VF(6), o1, 0, 0, 0);
            o0 = __builtin_amdgcn_mfma_f32_32x32x16_bf16(__builtin_bit_cast(bf16x8, pw3), ATT_VF(3), o0, 0, 0, 0);
            o1 = __builtin_amdgcn_mfma_f32_32x32x16_bf16(__builtin_bit_cast(bf16x8, pw3), ATT_VF(7), o1, 0, 0, 0);
#undef ATT_VF
        }
    }
#undef ATT_DMA
#undef ATT_TOK
    lsum = half_sum(lsum);
    if (hi == 0) wsf[32 + r32] = lsum;
    asm volatile("s_waitcnt lgkmcnt(0)" ::: "memory");
    LAS bf16_t* st = (LAS bf16_t*)(lds + L_OST) + wid * 2048;
#pragma unroll
    for (int r = 0; r < 16; ++r) { const int orow = crow(r, hi); const float rl = __builtin_amdgcn_rcpf(wsf[32 + orow]);
        st[orow * 64 + r32] = (bf16_t)(cvtpk(o0[r] * rl, 0.f) & 0xffffu); st[orow * 64 + 32 + r32] = (bf16_t)(cvtpk(o1[r] * rl, 0.f) & 0xffffu); }
    asm volatile("s_waitcnt lgkmcnt(0)" ::: "memory");
    const size_t tok0 = (size_t)b * SEQ + rq * 64 + 32 * (wid & 1);
#pragma unroll
    for (int i = 0; i < 4; ++i) { const int row = i * 8 + (lane >> 3), chn = lane & 7;
        const u32x4 v = *(const LAS u32x4*)(st + row * 64 + chn * 8); const size_t off = (tok0 + row) * 1024 + h * 64 + chn * 8;
        const u32x4 s = *(const u32x4*)(SGb + off);
        f32x4 a0, a1; a0[0] = bflo(v.x) * bflo(s.x); a0[1] = bfhi(v.x) * bfhi(s.x); a0[2] = bflo(v.y) * bflo(s.y); a0[3] = bfhi(v.y) * bfhi(s.y);
        a1[0] = bflo(v.z) * bflo(s.z); a1[1] = bfhi(v.z) * bfhi(s.z); a1[2] = bflo(v.w) * bflo(s.w); a1[3] = bfhi(v.w) * bfhi(s.w);
        *(u32x4*)(Z + off) = pg8::pack8(a0, a1); }
    asm volatile("s_waitcnt vmcnt(0) lgkmcnt(0)" ::: "memory");
    __builtin_amdgcn_s_barrier();
    asm volatile("" ::: "memory");
}
}
__device__ __forceinline__ void attn_mfma(Frame& F, const bf16_t* Q, const bf16_t* Kb, const bf16_t* Vb, const bf16_t* SGb, bf16_t* Z) {
    const int NU = NB * 16 * 8;
    const int per = (NU + F.G - 1) / F.G;
    for (int i = 0; i < per; ++i) { const int u = F.vcu * per + i; if (u >= NU) break;
        const int bh = u >> 3, rq4 = u & 7;
        att::attn_unit(F.lds, bh >> 4, bh & 15, rq4 * 4, Q, Kb, Vb, SGb, Z, F.na_rpb, F.tid, F.wave, F.lane); }
}

constexpr int NPHASE = 17;
__global__ void __launch_bounds__(NWAVES * 64, 2) fwd_mega(Args args) {
    extern __shared__ __attribute__((aligned(16))) unsigned char lds[];
    Frame F;
    F.lds = (LAS unsigned char*)lds;
    F.MISC = (volatile LAS unsigned*)(F.lds + MISC_OFF);
    F.tid = threadIdx.x; F.lane = F.tid & 63; F.wave = __builtin_amdgcn_readfirstlane(F.tid >> 6);
    F.G = gridDim.x; { const int bx = blockIdx.x; F.vcu = (F.G % 8 == 0) ? (bx % 8) * (F.G / 8) + bx / 8 : bx; }
    F.x = args.in[0]; F.c = args.in[1]; F.ctx = args.in[2]; F.c_ctx = args.in[3]; F.norm_g = args.in[4]; F.ada_w = args.in[5]; F.ada_b = args.in[6];
    F.pool_w_in = args.in[7]; F.pool_w_grp = args.in[8]; F.pool_scale = args.in[9]; F.pool_w_out = args.in[10]; F.na_w_in = args.in[11]; F.na_rpb = args.in[12]; F.na_w_out = args.in[13];
    F.conv_w_in = args.in[14]; F.conv_dw = args.in[15]; F.conv_db = args.in[16]; F.conv_w_out = args.in[17]; F.final_g = args.in[18];
    F.out = args.out; F.ws = args.ws;
    unsigned char* ws = args.ws;
    F.MOD = (float*)(ws + WS_MOD); F.CVEC = (float*)(ws + WS_CVEC); F.SSQ = (float*)(ws + WS_SSQ); F.XC = (float*)(ws + WS_XC);
    F.WPIN = (bf16_t*)(ws + WS_WPIN); F.WGRP = (bf16_t*)(ws + WS_WGRP); F.WPOUT = (bf16_t*)(ws + WS_WPOUT); F.WNIN = (bf16_t*)(ws + WS_WNIN); F.WNOUT = (bf16_t*)(ws + WS_WNOUT);
    F.WCIN = (bf16_t*)(ws + WS_WCIN); F.WCOUT = (bf16_t*)(ws + WS_WCOUT); F.XT = (bf16_t*)(ws + WS_XT); F.ACT0 = (bf16_t*)(ws + WS_ACT0);
    constexpr size_t AS = ACT_STRIDE / 2;
    bf16_t* const A0 = F.ACT0; bf16_t* const A1 = F.ACT0 + AS; bf16_t* const A2 = F.ACT0 + 2 * AS; bf16_t* const A3 = F.ACT0 + 3 * AS;

    for (int u = F.tid; u < (LDS_BYTES - LDSCTL_OFF) / 4; u += NWAVES * 64) ((LAS unsigned*)(F.lds + LDSCTL_OFF))[u] = 0u;
    __syncthreads();
    unsigned* barw = (unsigned*)(ws + WS_CTL) + CW_BAR;
    XcdBarrier bar; bar.bar = barw; bar.x = 0; bar.st = nullptr;
    if (!MK_PER_PHASE) bar = xcd_barrier_post(barw, F.MISC + 8);
    const int lo = args.ph_lo, hi = args.ph_hi;
#define IN(k) (lo <= (k) && (k) < hi)
#define SEAM(k) do { if (IN(k) && IN((k) + 1)) xcd_barrier(bar); } while (0)
    typedef pg8::StaticOrder SO;
    const int bid = (int)blockIdx.x;

    if (IN(0)) { p0_prologue(F); if (MK_REP == 0) { xcd_barrier(bar); p0_prologue(F); } } SEAM(0);
    if (IN(1)) { p1_prep(F); if (MK_REP == 1) { xcd_barrier(bar); p1_prep(F); } } SEAM(1);

#define REPEAT(PH, ...) do { __VA_ARGS__ if (MK_REP == (PH)) { xcd_barrier(bar); __VA_ARGS__ } } while (0)
#define POOL_LAYER(PH, LI, PJ, MROWS) \
    if (IN(PH)) { REPEAT(PH, { pg8::Gemm g{F.XT, F.WPIN + (size_t)(PJ) * 2048 * 1024, (MROWS), 2048, 1024, 1024, 1024, 0}; SO S; S.init((MROWS), 2048, F.G, bid); \
        pg8::EpiPool1 E{F.SSQ, F.CVEC + (size_t)(LI) * 9 * 4096, F.pool_scale + (PJ) * 1024, A0, A1}; \
        pg8::gemm_phase<pg8::EpiPool1, SO>(F.lds, g, S, E); }); } SEAM(PH); \
    if (IN((PH) + 1)) { REPEAT((PH) + 1, { e_pool(F, A0, A2, (MROWS)); }); } SEAM((PH) + 1); \
    if (IN((PH) + 2)) { REPEAT((PH) + 2, { pg8::Gemm g{A2, F.WGRP + (size_t)(PJ) * 4 * 65536, (MROWS), 1024, 256, 1024, 256, 256}; SO S; S.init((MROWS), 1024, F.G, bid); \
        pg8::EpiPool2 E{A1, A3}; \
        pg8::gemm_phase<pg8::EpiPool2, SO>(F.lds, g, S, E); }); } SEAM((PH) + 2);

    POOL_LAYER(2, 0, 0, MT)
    if (IN(5)) { REPEAT(5, { pg8::Gemm g{A3, F.WPOUT, MT, 1024, 1024, 1024, 1024, 0}; SO S; S.init(MT, 1024, F.G, bid);
        pg8::EpiOut E{F.x, F.ctx, F.out, F.XC, F.MOD + 0 * 9 * 3072 + 2048, F.norm_g + 1024, F.MOD + 1 * 9 * 3072 + 1024, F.XT, F.SSQ};
        pg8::gemm_phase<pg8::EpiOut, SO>(F.lds, g, S, E); }); } SEAM(5);

    if (IN(6)) { REPEAT(6, {
        { pg8::Gemm g{F.XT, F.WNIN, MX, 4096, 1024, 1024, 1024, 0}; SO S; S.init(MX, 4096, F.G, bid);
          pg8::EpiNa1 E{F.SSQ, F.CVEC + (size_t)1 * 9 * 4096, A0, AS, 0, -1};
          pg8::gemm_phase<pg8::EpiNa1, SO>(F.lds, g, S, E); }
        { pg8::Gemm g{F.XT + (size_t)MX * 1024, F.WNIN + (size_t)1024 * 1024, MC, 2048, 1024, 1024, 1024, 0}; SO S; S.init(MC, 2048, F.G, (bid + 128) % F.G);
          pg8::EpiNa1 E{F.SSQ + (size_t)MX * 16, F.CVEC + (size_t)1 * 9 * 4096 + 1024, A0 + (size_t)MX * 1024, AS, 1, 8};
          pg8::gemm_phase<pg8::EpiNa1, SO>(F.lds, g, S, E); }
    }); } SEAM(6);
#if MK_NAIVE_ATTN
    if (IN(7)) { attn_naive(F, A0, A1, A2, A3, A0); } SEAM(7);
#else
    if (IN(7)) { if (MK_REP == 7) { attn_mfma(F, A0, A1, A2, A3, F.XT); xcd_barrier(bar); } attn_mfma(F, A0, A1, A2, A3, A0); } SEAM(7);
#endif
    if (IN(8)) { pg8::Gemm g{A0, F.WNOUT, MX, 1024, 1024, 1024, 1024, 0}; SO S; S.init(MX, 1024, F.G, bid);
        pg8::EpiOut E{F.out, F.XC, F.out, F.XC, F.MOD + 1 * 9 * 3072 + 2048, F.norm_g + 2048, F.MOD + 2 * 9 * 3072 + 1024, F.XT, F.SSQ};
        pg8::gemm_phase<pg8::EpiOut, SO>(F.lds, g, S, E); } SEAM(8);

    if (IN(9)) { REPEAT(9, { pg8::Gemm g{F.XT, F.WCIN, MX, 4096, 1024, 1024, 1024, 0}; SO S; S.init(MX, 4096, F.G, bid);
        pg8::EpiConv1 E{F.SSQ, F.CVEC + (size_t)2 * 9 * 4096, A0, A1};
        pg8::gemm_phase<pg8::EpiConv1, SO>(F.lds, g, S, E); }); } SEAM(9);
    if (IN(10)) { REPEAT(10, { e_conv(F, A0, A1, A2); }); } SEAM(10);
    if (IN(11)) { pg8::Gemm g{A2, F.WCOUT, MX, 1024, 1024, 1024, 1024, 0}; SO S; S.init(MX, 1024, F.G, bid);
        pg8::EpiOut E{F.out, F.XC, F.out, F.XC, F.MOD + 2 * 9 * 3072 + 2048, F.norm_g + 3072, F.MOD + 3 * 9 * 3072 + 1024, F.XT, F.SSQ};
        pg8::gemm_phase<pg8::EpiOut, SO>(F.lds, g, S, E); } SEAM(11);

    POOL_LAYER(12, 3, 1, MX)
    if (IN(15)) { pg8::Gemm g{A3, F.WPOUT + (size_t)1024 * 1024, MX, 1024, 1024, 1024, 1024, 0}; SO S; S.init(MX, 1024, F.G, bid);
        pg8::EpiOut E{F.out, F.XC, F.out, F.XC, F.MOD + 3 * 9 * 3072 + 2048, nullptr, nullptr, F.XT, F.SSQ};
        pg8::gemm_phase<pg8::EpiOut, SO>(F.lds, g, S, E); } SEAM(15);
    if (IN(16)) { e_final(F); }
#undef IN
#undef SEAM
}

extern "C" void kernel_launch(void* const* d_in, const int* in_sizes, int n_in, void* d_out, int out_size, void* d_ws, size_t ws_size, hipStream_t stream) {
    static int grid = 0;
    if (grid == 0) {
        if (n_in != 19 || out_size != MX * DM || ws_size < WS_END) { fprintf(stderr, "kernel_launch: unexpected shapes (n_in %d, out %d, ws %zu); nothing launched\n", n_in, out_size, ws_size); grid = -1; return; }
        int dev = 0, cus = 0, per_cu = 0;
        if (hipGetDevice(&dev) != hipSuccess || hipDeviceGetAttribute(&cus, hipDeviceAttributeMultiprocessorCount, dev) != hipSuccess) { grid = -1; return; }
        if (hipFuncSetAttribute((const void*)fwd_mega, hipFuncAttributeMaxDynamicSharedMemorySize, LDS_BYTES) != hipSuccess) { fprintf(stderr, "kernel_launch: hipFuncSetAttribute failed\n"); grid = -1; return; }
        if (hipOccupancyMaxActiveBlocksPerMultiprocessor(&per_cu, (const void*)fwd_mega, NWAVES * 64, LDS_BYTES) != hipSuccess || per_cu < 1) { fprintf(stderr, "kernel_launch: occupancy query reports %d workgroups per CU\n", per_cu); (void)hipGetLastError(); grid = -1; return; }
        grid = cus;
    }
    if (grid < 0) return;
    (void)hipMemsetAsync((char*)d_ws + WS_CTL, 0, CTL_ZERO_BYTES, stream);
    Args a{};
    for (int i = 0; i < 19; ++i) a.in[i] = (const float*)d_in[i];
    a.out = (float*)d_out; a.ws = (unsigned char*)d_ws;
#if MK_PER_PHASE
    for (int p = 0; p < NPHASE; ++p) { a.ph_lo = p; a.ph_hi = p + 1; hipLaunchKernelGGL(fwd_mega, dim3(grid), dim3(NWAVES * 64), LDS_BYTES, stream, a); }
#else
    a.ph_lo = 0; a.ph_hi = NPHASE;
    hipLaunchKernelGGL(fwd_mega, dim3(grid), dim3(NWAVES * 64), LDS_BYTES, stream, a);
#endif
}
```

```cpp
#include <hip/hip_runtime.h>
#include <cstdio>
#include <cstdint>

#ifndef MK_PER_PHASE
#define MK_PER_PHASE 0
#endif
#ifndef MK_REP
#define MK_REP -1
#endif
#ifndef MK_NAIVE_ATTN
#define MK_NAIVE_ATTN 0
#endif

#define GAS __attribute__((address_space(1)))
#define LAS __attribute__((address_space(3)))
typedef unsigned short bf16_t;
typedef short bf16x8 __attribute__((ext_vector_type(8)));
typedef float f32x4 __attribute__((ext_vector_type(4)));
typedef unsigned u32x4 __attribute__((ext_vector_type(4)));
typedef unsigned u32x2 __attribute__((ext_vector_type(2)));
typedef float f32x2_t __attribute__((ext_vector_type(2)));
typedef __bf16 bf16x2_t __attribute__((ext_vector_type(2)));

constexpr int DM = 1024, NB = 8, SEQ = 2048, CTXL = 256;
constexpr int MX = NB * SEQ;
constexpr int MC = NB * CTXL;
constexpr int MT = MX + MC;
constexpr float EPS = 1e-6f;
constexpr float LOG2E = 1.4426950408889634f;
constexpr float QSCALE = 0.125f * LOG2E;

__device__ __forceinline__ unsigned cvtpk(float lo, float hi) { f32x2_t v = {lo, hi}; bf16x2_t b = __builtin_convertvector(v, bf16x2_t); return __builtin_bit_cast(unsigned, b); }
__device__ __forceinline__ float bflo(unsigned u) { return __builtin_bit_cast(float, u << 16); }
__device__ __forceinline__ float bfhi(unsigned u) { return __builtin_bit_cast(float, u & 0xffff0000u); }
__device__ __forceinline__ float silu_f(float v) { return v * __builtin_amdgcn_rcpf(1.0f + __builtin_amdgcn_exp2f(-LOG2E * v)); }
__device__ __forceinline__ float wave_sum(float v) {
#pragma unroll
    for (int o = 1; o < 64; o <<= 1) v += __shfl_xor(v, o);
    return v;
}
__device__ __forceinline__ float wave_max(float v) {
#pragma unroll
    for (int o = 1; o < 64; o <<= 1) v = fmaxf(v, __shfl_xor(v, o));
    return v;
}

namespace pg8 {
#define PG8_LAS __attribute__((address_space(3)))
constexpr int BM = 256, BK = 64, HALF = 128, HTB = HALF * BK * 2, STAGE_BYTES = 8 * HTB, NXCD = 8, WGM = 8;

__host__ __device__ __forceinline__ int lds_byte(int r, int c) { const int st = (r >> 4) * 2 + (c >> 5), rr = r & 15, cc = c & 31, ob = rr * 64 + cc * 2; return st * 1024 + (ob ^ (((ob >> 9) & 1) << 5)); }
__host__ __device__ __forceinline__ void stage_rc(int b, int& R, int& C) { const int st = b / 1024, sb = b % 1024, swz = sb ^ (((sb >> 9) & 1) << 5); R = (st >> 1) * 16 + swz / 64; C = (st & 1) * 32 + (swz % 64) / 2; }
__host__ __device__ __forceinline__ int perm32(int rho) { const int n = rho >> 4, i = rho & 15; return 8 * (i >> 2) + 4 * n + (i & 3); }

struct Unit { int pm, pn; };
struct Gemm { const bf16_t* A; const bf16_t* Bt; int M, N, K, lda, ldb, bcol; };

struct StaticOrder {
    int nM, nN, nwg, G, c;
    __host__ __device__ void init(int M, int N, int G_, int c_) { nM = M / BM; nN = N / BM; nwg = nM * nN; G = G_; c = c_; }
    __host__ __device__ bool next(int i, Unit& u) const {
        const long L = (long)i * G + c; if (L >= nwg) return false;
        int wgid = (int)L; { const int q = nwg / NXCD, r = nwg % NXCD, xcd = wgid % NXCD, off = wgid / NXCD; wgid = (xcd < r ? xcd * (q + 1) : r * (q + 1) + (xcd - r) * q) + off; }
        const int nig = WGM * nN, gid = wgid / nig, fm = gid * WGM, gsz = (nM - fm) < WGM ? (nM - fm) : WGM;
        u.pm = fm + ((wgid % nig) % gsz); u.pn = (wgid % nig) / gsz; return true;
    }
};

template <class Epi, class Sched, bool ALIGN_EPI = true>
__device__ __forceinline__ void gemm_phase(PG8_LAS unsigned char* lds, const Gemm g, const Sched& S, const Epi& E) {
    const int tid = threadIdx.x, wid = __builtin_amdgcn_readfirstlane(tid >> 6), lane = tid & 63, wr = wid >> 2, wc = wid & 3, fr = lane & 15, fq = lane >> 4;
    const int K = g.K, nt = K / BK;
    unsigned voffA[2], voffB[2];
#pragma unroll
    for (int i = 0; i < 2; ++i) { int R, C; stage_rc(tid * 16 + i * 8192, R, C); const int Rb = Epi::PERM ? ((R & ~31) + perm32(R & 31)) : R;
        voffA[i] = (unsigned)(R * g.lda + C) * 2u; voffB[i] = (unsigned)(Rb * g.ldb + C) * 2u; }
    const size_t kstep = (size_t)(BK * 2);
    const size_t hstepA = (size_t)HALF * g.lda * 2, hstepB = (size_t)HALF * g.ldb * 2;
    const size_t tstepA = 2 * hstepA, tstepB = 2 * hstepB;
    const unsigned ldsw = (unsigned)wid * 1024u;
    const int aoff = lds_byte(wr * 64 + fr, fq * 8), boff = lds_byte(wc * 32 + fr, fq * 8);
#define PG8_SA(b, h) (((b) * 2 + (h)) * HTB)
#define PG8_SB(b, h) ((4 + (b) * 2 + (h)) * HTB)
#define PG8_STAGE(bufoff, gbase, voff) do { _Pragma("unroll") for (int _i = 0; _i < 2; ++_i) \
        __builtin_amdgcn_global_load_lds((const unsigned*)((const char*)(gbase) + (voff)[_i]), (PG8_LAS unsigned*)(lds + (bufoff) + ldsw + _i * 8192), 16, 0, 0); } while (0)
#define PG8_LDA(dst, b, h) do { _Pragma("unroll") for (int m = 0; m < 4; ++m) _Pragma("unroll") for (int k = 0; k < 2; ++k) dst[m][k] = *(const PG8_LAS bf16x8*)(lds + PG8_SA(b, h) + aoff + m * 2048 + k * 1024); } while (0)
#define PG8_LDB(dst, b, h) do { _Pragma("unroll") for (int n = 0; n < 2; ++n) _Pragma("unroll") for (int k = 0; k < 2; ++k) dst[n][k] = *(const PG8_LAS bf16x8*)(lds + PG8_SB(b, h) + boff + n * 2048 + k * 1024); } while (0)
#define PG8_MMA(ai, bj, At, Bt) do { __builtin_amdgcn_s_setprio(1); _Pragma("unroll") for (int m = 0; m < 4; ++m) _Pragma("unroll") for (int n = 0; n < 2; ++n) _Pragma("unroll") for (int k = 0; k < 2; ++k) \
        acc[ai][bj][m][n] = __builtin_amdgcn_mfma_f32_16x16x32_bf16(Bt[n][k], At[m][k], acc[ai][bj][m][n], 0, 0, 0); __builtin_amdgcn_s_setprio(0); } while (0)
#define PG8_WAIT_V(n) asm volatile("s_waitcnt vmcnt(" #n ")" ::: "memory")
#define PG8_WAIT_L(n) asm volatile("s_waitcnt lgkmcnt(" #n ")" ::: "memory")
#define PG8_BAR __builtin_amdgcn_s_barrier()
#define PG8_SCHED __builtin_amdgcn_sched_barrier(0)
    Unit cur, nxt; int ui = 0;
    if (!S.next(0, cur)) return;
    f32x4 acc[2][2][4][2];
#pragma unroll
    for (int a = 0; a < 2; ++a)
#pragma unroll
        for (int b = 0; b < 2; ++b)
#pragma unroll
            for (int m = 0; m < 4; ++m)
#pragma unroll
                for (int n = 0; n < 2; ++n) acc[a][b][m][n] = (f32x4){0.f, 0.f, 0.f, 0.f};
    bf16x8 At[4][2], B0[2][2], B1[2][2];
    const char* cA = (const char*)g.A + (size_t)cur.pm * tstepA; const char* cB = (const char*)g.Bt + (size_t)cur.pn * tstepB + (size_t)cur.pm * g.bcol * 2;
    PG8_STAGE(PG8_SB(0, 0), cB, voffB); PG8_STAGE(PG8_SB(0, 1), cB + hstepB, voffB); PG8_STAGE(PG8_SA(0, 0), cA, voffA); PG8_STAGE(PG8_SA(0, 1), cA + hstepA, voffA);
    if (wr == 1) PG8_BAR;
    PG8_WAIT_V(2); PG8_BAR;
    PG8_STAGE(PG8_SB(1, 0), cB + kstep, voffB); PG8_STAGE(PG8_SA(1, 0), cA + kstep, voffA); PG8_STAGE(PG8_SB(1, 1), cB + hstepB + kstep, voffB);
    PG8_WAIT_V(6); PG8_BAR;
    for (;;) {
        const bool has_next = S.next(ui + 1, nxt);
        const char* nA = has_next ? (const char*)g.A + (size_t)nxt.pm * tstepA : cA; const char* nB = has_next ? (const char*)g.Bt + (size_t)nxt.pn * tstepB + (size_t)nxt.pm * g.bcol * 2 : cB;
#pragma nounroll
        for (int t = 0; t < nt; t += 2) {
            const bool last = (t == nt - 2);
            const char* a1 = cA + (size_t)(t + 1) * kstep;
            const char* a2 = last ? nA : cA + (size_t)(t + 2) * kstep; const char* b2 = last ? nB : cB + (size_t)(t + 2) * kstep;
            const char* a3 = a2 + kstep; const char* b3 = b2 + kstep;
            PG8_LDB(B0, 0, 0); PG8_LDB(B1, 0, 1); PG8_SCHED; PG8_LDA(At, 0, 0); PG8_STAGE(PG8_SA(1, 1), a1 + hstepA, voffA);
            PG8_WAIT_V(8); PG8_WAIT_L(0); PG8_BAR; PG8_MMA(0, 0, At, B0); PG8_MMA(0, 1, At, B1); PG8_BAR; PG8_SCHED;
            PG8_LDA(At, 0, 1); PG8_STAGE(PG8_SB(0, 0), b2, voffB); PG8_STAGE(PG8_SB(0, 1), b2 + hstepB, voffB); PG8_STAGE(PG8_SA(0, 0), a2, voffA);
            PG8_WAIT_V(8); PG8_WAIT_L(0); PG8_BAR; PG8_MMA(1, 0, At, B0); PG8_MMA(1, 1, At, B1); PG8_BAR; PG8_SCHED;
            PG8_LDB(B0, 1, 0); PG8_LDB(B1, 1, 1); PG8_SCHED; PG8_LDA(At, 1, 0); PG8_STAGE(PG8_SA(0, 1), a2 + hstepA, voffA);
            PG8_WAIT_V(8); PG8_WAIT_L(0); PG8_BAR; PG8_MMA(0, 0, At, B0); PG8_MMA(0, 1, At, B1); PG8_BAR; PG8_SCHED;
            PG8_LDA(At, 1, 1); PG8_STAGE(PG8_SB(1, 0), b3, voffB); PG8_STAGE(PG8_SB(1, 1), b3 + hstepB, voffB); PG8_STAGE(PG8_SA(1, 0), a3, voffA);
            PG8_WAIT_V(8); PG8_WAIT_L(0); PG8_BAR; PG8_MMA(1, 0, At, B0); PG8_MMA(1, 1, At, B1); PG8_BAR; PG8_SCHED;
        }
        if constexpr (ALIGN_EPI) { if (wr == 0) PG8_BAR; }
        E(acc, cur, wr, wc, fr, fq);
        if (!has_next) break;
#pragma unroll
        for (int a = 0; a < 2; ++a)
#pragma unroll
            for (int b = 0; b < 2; ++b)
#pragma unroll
                for (int m = 0; m < 4; ++m)
#pragma unroll
                    for (int n = 0; n < 2; ++n) acc[a][b][m][n] = (f32x4){0.f, 0.f, 0.f, 0.f};
        cur = nxt; cA = nA; cB = nB; ++ui;
        if constexpr (ALIGN_EPI) { if (wr == 1) PG8_BAR; }
    }
    PG8_WAIT_V(0);
    if constexpr (!ALIGN_EPI) { if (wr == 0) PG8_BAR; }
    PG8_BAR;
#undef PG8_SA
#undef PG8_SB
#undef PG8_STAGE
#undef PG8_LDA
#undef PG8_LDB
#undef PG8_MMA
#undef PG8_WAIT_V
#undef PG8_WAIT_L
#undef PG8_BAR
#undef PG8_SCHED
}

__device__ __forceinline__ float row_rstd(const float* ssq, int row) {
    const f32x4* p = (const f32x4*)(ssq + (size_t)row * 16);
    const f32x4 a = p[0], b = p[1], c = p[2], d = p[3];
    const float s = ((a.x + a.y) + (a.z + a.w)) + ((b.x + b.y) + (b.z + b.w)) + ((c.x + c.y) + (c.z + c.w)) + ((d.x + d.y) + (d.z + d.w));
    return rsqrtf(s * (1.0f / 1024.0f) + EPS);
}

__device__ __forceinline__ void rows_rstd(const float* ssq, int rowbase, int fq, float (&rs)[8]) {
    f32x4 q[8];
#pragma unroll
    for (int g = 0; g < 8; ++g) q[g] = *(const f32x4*)(ssq + (size_t)(rowbase + (g >> 2) * 128 + (g & 3) * 16) * 16 + fq * 4);
#pragma unroll
    for (int g = 0; g < 8; ++g) { float t = (q[g].x + q[g].y) + (q[g].z + q[g].w); t += __shfl_xor(t, 16); t += __shfl_xor(t, 32); rs[g] = rsqrtf(t * (1.0f / 1024.0f) + EPS); }
}
__device__ __forceinline__ u32x4 pack8(const f32x4 v0, const f32x4 v1) { u32x4 w; w.x = cvtpk(v0[0], v0[1]); w.y = cvtpk(v0[2], v0[3]); w.z = cvtpk(v1[0], v1[1]); w.w = cvtpk(v1[2], v1[3]); return w; }

struct EpiPool1 {
    static constexpr bool PERM = true;
    const float* ssq; const float* cvec; const float* pscale; bf16_t* U; bf16_t* SG;
    __device__ __forceinline__ void operator()(const f32x4 (&acc)[2][2][4][2], const Unit& u, int wr, int wc, int fr, int fq) const {
        const int bm = u.pm < 64 ? (u.pm >> 3) : 8;
        const bool isg = u.pn >= 4;
        const int ct = u.pn * 256 + wc * 32 + 8 * fq, co = (u.pn & 3) * 256 + wc * 32 + 8 * fq;
        f32x4 cv[2][2], sc[2][2];
#pragma unroll
        for (int bj = 0; bj < 2; ++bj)
#pragma unroll
            for (int n = 0; n < 2; ++n) { cv[bj][n] = *(const f32x4*)(cvec + (size_t)bm * 4096 + ct + bj * 128 + 4 * n);
                sc[bj][n] = isg ? *(const f32x4*)(pscale + co + bj * 128 + 4 * n) : (f32x4){1.f, 1.f, 1.f, 1.f}; }
        bf16_t* O = isg ? SG : U;
        float rsv[8]; rows_rstd(ssq, u.pm * 256 + wr * 64 + fr, fq, rsv);
#pragma unroll
        for (int ai = 0; ai < 2; ++ai)
#pragma unroll
            for (int m = 0; m < 4; ++m) { const int row = u.pm * 256 + ai * 128 + wr * 64 + m * 16 + fr; const float rs = rsv[ai * 4 + m];
#pragma unroll
                for (int bj = 0; bj < 2; ++bj) { f32x4 v0 = acc[ai][bj][m][0] * rs + cv[bj][0], v1 = acc[ai][bj][m][1] * rs + cv[bj][1];
                    if (isg) {
#pragma unroll
                        for (int j = 0; j < 4; ++j) { v0[j] = sc[bj][0][j] * silu_f(v0[j]); v1[j] = sc[bj][1][j] * silu_f(v1[j]); } }
                    *(u32x4*)(O + (size_t)row * 1024 + co + bj * 128) = pack8(v0, v1); }
                if (m & 1) asm volatile("" ::: "memory"); }
    }
};
struct EpiFold {
    static constexpr bool PERM = true;
    bf16_t* O;
    __device__ __forceinline__ void operator()(const f32x4 (&acc)[2][2][4][2], const Unit& u, int wr, int wc, int fr, int fq) const {
        const int co = u.pn * 256 + wc * 32 + 8 * fq;
#pragma unroll
        for (int ai = 0; ai < 2; ++ai)
#pragma unroll
            for (int m = 0; m < 4; ++m) { const int row = u.pm * 256 + ai * 128 + wr * 64 + m * 16 + fr; const int orow = row + (row >= 1024 ? 1024 : 0);
#pragma unroll
                for (int bj = 0; bj < 2; ++bj) *(u32x4*)(O + (size_t)orow * 1024 + co + bj * 128) = pack8(acc[ai][bj][m][0], acc[ai][bj][m][1]); }
    }
};
struct EpiNa1 {
    static constexpr bool PERM = true;
    const float* ssq; const float* cvec; bf16_t* out; size_t tstride; int tbase; int bmfix;
    __device__ __forceinline__ void operator()(const f32x4 (&acc)[2][2][4][2], const Unit& u, int wr, int wc, int fr, int fq) const {
        const int bm = bmfix >= 0 ? bmfix : (u.pm >> 3);
        const int t = tbase + (u.pn >> 2);
        const int ct = u.pn * 256 + wc * 32 + 8 * fq, co = (u.pn & 3) * 256 + wc * 32 + 8 * fq;
        f32x4 cv[2][2];
#pragma unroll
        for (int bj = 0; bj < 2; ++bj)
#pragma unroll
            for (int n = 0; n < 2; ++n) cv[bj][n] = *(const f32x4*)(cvec + (size_t)bm * 4096 + ct + bj * 128 + 4 * n);
        bf16_t* O = out + (size_t)t * tstride;
        float rsv[8]; rows_rstd(ssq, u.pm * 256 + wr * 64 + fr, fq, rsv);
#pragma unroll
        for (int ai = 0; ai < 2; ++ai)
#pragma unroll
            for (int m = 0; m < 4; ++m) { const int row = u.pm * 256 + ai * 128 + wr * 64 + m * 16 + fr; const float rs = rsv[ai * 4 + m];
#pragma unroll
                for (int bj = 0; bj < 2; ++bj) { f32x4 v0 = acc[ai][bj][m][0] * rs + cv[bj][0], v1 = acc[ai][bj][m][1] * rs + cv[bj][1];
                    if (t == 0) { v0 = v0 * QSCALE; v1 = v1 * QSCALE; }
                    if (t == 3) {
#pragma unroll
                        for (int j = 0; j < 4; ++j) { v0[j] = silu_f(v0[j]); v1[j] = silu_f(v1[j]); } }
                    *(u32x4*)(O + (size_t)row * 1024 + co + bj * 128) = pack8(v0, v1); }
                if (m & 1) asm volatile("" ::: "memory"); }
    }
};
struct EpiConv1 {
    static constexpr bool PERM = true;
    const float* ssq; const float* cvec; bf16_t* P; bf16_t* S;
    __device__ __forceinline__ void operator()(const f32x4 (&acc)[2][2][4][2], const Unit& u, int wr, int wc, int fr, int fq) const {
        const int bm = u.pm >> 3;
        const int ct = u.pn * 256 + wc * 32 + 8 * fq, ch0 = u.pn * 64 + wc * 16 + 4 * fq;
        f32x4 cv[2][2];
#pragma unroll
        for (int bj = 0; bj < 2; ++bj)
#pragma unroll
            for (int n = 0; n < 2; ++n) cv[bj][n] = *(const f32x4*)(cvec + (size_t)bm * 4096 + ct + bj * 128 + 4 * n);
        float rsv[8]; rows_rstd(ssq, u.pm * 256 + wr * 64 + fr, fq, rsv);
#pragma unroll
        for (int ai = 0; ai < 2; ++ai)
#pragma unroll
            for (int m = 0; m < 4; ++m) { const int row = u.pm * 256 + ai * 128 + wr * 64 + m * 16 + fr; const float rs = rsv[ai * 4 + m];
                const f32x4 bg = acc[ai][0][m][0] * rs + cv[0][0], cg = acc[ai][0][m][1] * rs + cv[0][1], vv = acc[ai][1][m][0] * rs + cv[1][0], gg = acc[ai][1][m][1] * rs + cv[1][1];
                f32x4 p = cg * vv, s;
#pragma unroll
                for (int j = 0; j < 4; ++j) s[j] = bg[j] * silu_f(gg[j]);
                u32x2 pw, sw; pw.x = cvtpk(p[0], p[1]); pw.y = cvtpk(p[2], p[3]); sw.x = cvtpk(s[0], s[1]); sw.y = cvtpk(s[2], s[3]);
                *(u32x2*)(P + (size_t)row * 1024 + ch0) = pw; *(u32x2*)(S + (size_t)row * 1024 + ch0) = sw;
                if (m & 1) asm volatile("" ::: "memory"); }
    }
};
struct EpiOut {
    static constexpr bool PERM = false;
    const float* basex; const float* basec; float* outx; float* outc;
    const float* gate;
    const float* gnext;
    const float* scnext;
    bf16_t* XT; float* ssq;
    __device__ __forceinline__ void operator()(const f32x4 (&acc)[2][2][4][2], const Unit& u, int wr, int wc, int fr, int fq) const {
        const bool isc = u.pm >= 64; const int bm = isc ? 8 : (u.pm >> 3);
        const int col0 = u.pn * 256 + wc * 32 + 4 * fq;
        f32x4 gt[2][2], an[2][2];
#pragma unroll
        for (int bj = 0; bj < 2; ++bj)
#pragma unroll
            for (int n = 0; n < 2; ++n) { gt[bj][n] = *(const f32x4*)(gate + (size_t)bm * 3072 + col0 + bj * 128 + n * 16);
                if (gnext) an[bj][n] = *(const f32x4*)(gnext + col0 + bj * 128 + n * 16) * (*(const f32x4*)(scnext + (size_t)bm * 3072 + col0 + bj * 128 + n * 16) + 1.0f);
                else an[bj][n] = (f32x4){0.f, 0.f, 0.f, 0.f}; }
        const float* bp = isc ? basec - (size_t)MX * 1024 : basex; float* op = isc ? outc - (size_t)MX * 1024 : outx;
        const size_t off0 = (size_t)(u.pm * 256 + wr * 64 + fr) * 1024 + col0;
        f32x4 xin[2][2][2];
#define EO_OFF(g) (off0 + (size_t)(((g) >> 2) * 128 + ((g) & 3) * 16) * 1024)
#define EO_LOAD(g) do { _Pragma("unroll") for (int bj = 0; bj < 2; ++bj) _Pragma("unroll") for (int n = 0; n < 2; ++n) xin[(g) & 1][bj][n] = *(const f32x4*)(bp + EO_OFF(g) + bj * 128 + n * 16); } while (0)
        EO_LOAD(0);
#pragma unroll
        for (int g = 0; g < 8; ++g) { const int ai = g >> 2, m = g & 3; const size_t off = EO_OFF(g); float s = 0.f;
            if (g + 1 < 8) EO_LOAD(g + 1);
#pragma unroll
            for (int bj = 0; bj < 2; ++bj)
#pragma unroll
                for (int n = 0; n < 2; ++n) { const f32x4 y = xin[g & 1][bj][n] + gt[bj][n] * acc[ai][bj][m][n];
                    *(f32x4*)(op + off + bj * 128 + n * 16) = y; s += (y[0] * y[0] + y[1] * y[1]) + (y[2] * y[2] + y[3] * y[3]);
                    if (gnext) { const f32x4 tt = y * an[bj][n]; u32x2 w; w.x = cvtpk(tt[0], tt[1]); w.y = cvtpk(tt[2], tt[3]); *(u32x2*)(XT + off + bj * 128 + n * 16) = w; } }
            s += __shfl_xor(s, 16); s += __shfl_xor(s, 32);
            if (fq == 0) ssq[(size_t)(u.pm * 256 + wr * 64 + fr + ai * 128 + m * 16) * 16 + u.pn * 4 + wc] = s;
            asm volatile("" ::: "memory"); }
#undef EO_LOAD
#undef EO_OFF
    }
};
}

constexpr size_t MiB = 1u << 20;
constexpr size_t WS_CTL = 0, CTL_ZERO_BYTES = 1 * MiB;
constexpr size_t WS_MOD = 1 * MiB;
constexpr size_t WS_CVEC = 2 * MiB;
constexpr size_t WS_SSQ = 3 * MiB;
constexpr size_t WS_WPIN = 6 * MiB;
constexpr size_t WS_WGRP = 14 * MiB;
constexpr size_t WS_WPOUT = 15 * MiB;
constexpr size_t WS_WNIN = 19 * MiB;
constexpr size_t WS_WNOUT = 27 * MiB;
constexpr size_t WS_WCIN = 29 * MiB;
constexpr size_t WS_WCOUT = 37 * MiB;
constexpr size_t WS_XC = 40 * MiB;
constexpr size_t WS_XT = 48 * MiB;
constexpr size_t WS_ACT0 = 84 * MiB, ACT_STRIDE = 36 * MiB;
constexpr size_t WS_WU = 228 * MiB;
constexpr size_t WS_END = 232 * MiB;
constexpr int CW_BAR = 4096;

#define XB_TMO      128
#define XB_XCNT(j)  (256  + 64 * (j))
#define XB_XSUB(j)  (1280 + 64 * (j))
#define XB_XGEN(j)  (2304 + 64 * (j))
#define XB_TOP      3328
#define XB_TOPGEN   3392
#define XCD_BAR_WORDS 3456
#define XB_SPIN_CAP (1u << 18)
__device__ __forceinline__ unsigned xb_ld(unsigned* p)              { return __hip_atomic_load(p, __ATOMIC_RELAXED, __HIP_MEMORY_SCOPE_AGENT); }
__device__ __forceinline__ unsigned xb_add(unsigned* p, unsigned v) { return __hip_atomic_fetch_add(p, v, __ATOMIC_RELAXED, __HIP_MEMORY_SCOPE_AGENT); }
__device__ __forceinline__ unsigned xb_xcc_id() { return (unsigned)__builtin_amdgcn_s_getreg((3 << 11) | 20) & 0xFu; }
#define XB_SPIN(cond, bar) do { unsigned _sp = 0; while (cond) { __builtin_amdgcn_s_sleep(1); \
    if ((++_sp & 255u) == 0u) { if (xb_ld(&(bar)[XB_TMO])) break; if (_sp > XB_SPIN_CAP) { atomicAdd(&(bar)[XB_TMO], 1u); break; } } } } while (0)
struct XcdBarrier { unsigned* bar; unsigned x; volatile LAS unsigned* st; };
__device__ __forceinline__ XcdBarrier xcd_barrier_post(unsigned* bar, volatile LAS unsigned* st) {
    XcdBarrier b; b.bar = bar; b.x = xb_xcc_id(); b.st = st;
    if (threadIdx.x == 0) (void)xb_add(&bar[XB_XCNT(b.x)], 1u);
    return b;
}
__device__ __forceinline__ void xcd_barrier_complete(unsigned* bar, unsigned x, unsigned& nloc, unsigned& nx) {
    const unsigned G = gridDim.x * gridDim.y * gridDim.z;
    unsigned sum, cnt, mine, sp = 0u;
    for (;;) {
        sum = 0u; cnt = 0u; mine = 0u;
#pragma unroll
        for (unsigned j = 0; j < 16; ++j) { const unsigned c = xb_ld(&bar[XB_XCNT(j)]); sum += c; cnt += (c > 0u) ? 1u : 0u; mine = (j == x) ? c : mine; }
        if (sum == G) break;
        __builtin_amdgcn_s_sleep(1);
        if ((++sp & 255u) == 0u) { if (xb_ld(&bar[XB_TMO])) break; if (sp > XB_SPIN_CAP) { atomicAdd(&bar[XB_TMO], 1u); break; } }
    }
    nloc = mine > 0u ? mine : 1u; nx = cnt > 0u ? cnt : 1u;
}
__device__ __forceinline__ void xcd_barrier(const XcdBarrier& b) {
    asm volatile("s_waitcnt vmcnt(0)" ::: "memory");
    __syncthreads();
    if (threadIdx.x == 0) {
        unsigned* bar = b.bar;
        __builtin_amdgcn_s_waitcnt(0);
        unsigned nloc = b.st[0], nx = b.st[1];
        if (nloc == 0u) { xcd_barrier_complete(bar, b.x, nloc, nx); b.st[0] = nloc; b.st[1] = nx; }
        const unsigned old = xb_add(&bar[XB_XSUB(b.x)], 1u);
        const unsigned gen = old / nloc;
        if (old + 1u == (gen + 1u) * nloc) {
            __builtin_amdgcn_fence(__ATOMIC_RELEASE, "agent");
            asm volatile("s_waitcnt vmcnt(0)" ::: "memory");
            const unsigned og = xb_add(&bar[XB_TOP], 1u);
            const unsigned tg = og / nx;
            if (og + 1u == (tg + 1u) * nx) xb_add(&bar[XB_TOPGEN], 1u);
            else XB_SPIN(xb_ld(&bar[XB_TOPGEN]) == tg, bar);
            __builtin_amdgcn_fence(__ATOMIC_ACQUIRE, "agent");
            xb_add(&bar[XB_XGEN(b.x)], 1u);
            asm volatile("s_waitcnt vmcnt(0)" ::: "memory");
        } else {
            XB_SPIN(xb_ld(&bar[XB_XGEN(b.x)]) == gen, bar);
            __builtin_amdgcn_fence(__ATOMIC_ACQUIRE, "agent");
            asm volatile("s_waitcnt vmcnt(0)" ::: "memory");
        }
    }
    __syncthreads();
}

constexpr int NWAVES = 8;
constexpr int RING_BYTES = 131072, LDSCTL_OFF = RING_BYTES, MISC_OFF = LDSCTL_OFF + 320, LDS_BYTES = 147456;

struct Args { const float* in[19]; float* out; unsigned char* ws; int ph_lo, ph_hi; };

struct Frame {
    LAS unsigned char* lds; volatile LAS unsigned* MISC;
    int tid, lane, wave, vcu, G;
    const float *x, *c, *ctx, *c_ctx, *norm_g, *ada_w, *ada_b, *pool_w_in, *pool_w_grp, *pool_scale, *pool_w_out, *na_w_in, *na_rpb, *na_w_out, *conv_w_in, *conv_dw, *conv_db, *conv_w_out, *final_g;
    float* out; unsigned char* ws;
    float *MOD, *CVEC, *SSQ, *XC;
    bf16_t *WPIN, *WGRP, *WPOUT, *WNIN, *WNOUT, *WCIN, *WCOUT, *XT, *ACT0, *WU;
};

__device__ __forceinline__ void p0_mod_task(Frame& F, int task) {
    const int layer = task / 48, col0 = (task % 48) * 64;
    LAS float* sc = (LAS float*)F.lds;
    LAS float* red = sc + 9 * 1024;
    for (int i = F.tid; i < 9 * 1024; i += NWAVES * 64) { const int b = i >> 10, k = i & 1023; const float v = (b < 8) ? F.c[b * 1024 + k] : F.c_ctx[k]; sc[i] = silu_f(v); }
    __syncthreads();
    const float* W = F.ada_w + (size_t)layer * 1024 * 3072 + col0;
    const int kr = F.lane >> 4, cl = (F.lane & 15) * 4;
    float acc[9][4];
#pragma unroll
    for (int b = 0; b < 9; ++b)
#pragma unroll
        for (int j = 0; j < 4; ++j) acc[b][j] = 0.f;
    const int kbase = F.wave * 128;
#pragma unroll 4
    for (int it = 0; it < 32; ++it) { const int k = kbase + it * 4 + kr; const f32x4 w = *(const f32x4*)(W + (size_t)k * 3072 + cl);
#pragma unroll
        for (int b = 0; b < 9; ++b) { const float s = sc[b * 1024 + k];
#pragma unroll
            for (int j = 0; j < 4; ++j) acc[b][j] += s * w[j]; } }
#pragma unroll
    for (int b = 0; b < 9; ++b)
#pragma unroll
        for (int j = 0; j < 4; ++j) { float v = acc[b][j]; v += __shfl_xor(v, 16); v += __shfl_xor(v, 32); acc[b][j] = v; }
    if (kr == 0) {
#pragma unroll
        for (int b = 0; b < 9; ++b)
#pragma unroll
            for (int j = 0; j < 4; ++j) red[(F.wave * 9 + b) * 64 + cl + j] = acc[b][j]; }
    __syncthreads();
    for (int o = F.tid; o < 576; o += NWAVES * 64) { const int b = o >> 6, cc = o & 63; float s = 0.f;
#pragma unroll
        for (int w = 0; w < 8; ++w) s += red[(w * 9 + b) * 64 + cc];
        F.MOD[(size_t)(layer * 9 + b) * 3072 + col0 + cc] = s + F.ada_b[layer * 3072 + col0 + cc]; }
    __syncthreads();
}
__device__ __forceinline__ unsigned f2bf(float f) { unsigned u = __builtin_bit_cast(unsigned, f); return (u + 0x7fffu + ((u >> 16) & 1u)) >> 16; }
__device__ __forceinline__ unsigned pk2(float lo, float hi) { return f2bf(lo) | (f2bf(hi) << 16); }
__device__ __forceinline__ int conv_row(int n) { const int split = n >> 10, ch = n & 1023; return (ch >> 6) * 256 + (split >> 1) * 128 + ((ch >> 4) & 3) * 32 + ((ch >> 2) & 3) * 8 + (split & 1) * 4 + (ch & 3); }
template <int MODE>
__device__ __forceinline__ void p0_transpose_item(const float* W, int K, int N, bf16_t* WT, LAS float* scr, int item, int lane) {
    const int nblk = N / 32, kb = item / nblk, nb = item % nblk, k0 = 64 * kb, n0 = 32 * nb;
#pragma unroll 8
    for (int i = 0; i < 32; ++i) { const int kk = 2 * i + (lane >> 5); scr[kk * 33 + (lane & 31)] = W[(size_t)(k0 + kk) * N + n0 + (lane & 31)]; }
    asm volatile("s_waitcnt lgkmcnt(0)" ::: "memory");
    const int c = lane & 7;
#pragma unroll
    for (int j = 0; j < 4; ++j) { const int n = (lane >> 3) + 8 * j; const LAS float* s = scr + (8 * c) * 33 + n;
        u32x4 o; o.x = pk2(s[0 * 33], s[1 * 33]); o.y = pk2(s[2 * 33], s[3 * 33]); o.z = pk2(s[4 * 33], s[5 * 33]); o.w = pk2(s[6 * 33], s[7 * 33]);
        const int drow = MODE == 1 ? conv_row(n0 + n) : (n0 + n);
        *(u32x4*)(WT + (size_t)drow * K + k0 + 8 * c) = o; }
    asm volatile("s_waitcnt lgkmcnt(0)" ::: "memory");
}
__device__ __forceinline__ void p0_prologue(Frame& F) {
    for (int t = (int)blockIdx.x; t < 192; t += F.G) p0_mod_task(F, t);
    LAS float* scr = (LAS float*)(F.lds + F.wave * 16384);
    const int gw = F.vcu * NWAVES + F.wave, NGW = F.G * NWAVES;
    constexpr int I_PIN = 16 * 64, I_GRP = 4 * 8, I_SQ = 16 * 32, I_BIG = 16 * 128;
    constexpr int NITEMS = 2 * I_PIN + 8 * I_GRP + 2 * I_SQ + I_BIG + I_SQ + I_BIG + I_SQ;
    for (int it = gw; it < NITEMS; it += NGW) {
        int r = it;
        if (r < 2 * I_PIN) { const int j = r / I_PIN, it2 = r % I_PIN, nb = it2 % 64;
            if (nb >= 32) p0_transpose_item<0>(F.pool_w_in + (size_t)j * 1024 * 2048, 1024, 2048, F.WPIN + (size_t)j * 2048 * 1024, scr, it2, F.lane);
            else { const int kb = it2 / 64, k0 = 64 * kb, n0 = 32 * nb;
#pragma unroll 4
                for (int i = 0; i < 8; ++i) { const int kk = 8 * i + (F.lane >> 3), c4 = (F.lane & 7) * 4; const f32x4 v = *(const f32x4*)(F.pool_w_in + (size_t)j * 1024 * 2048 + (size_t)(k0 + kk) * 2048 + n0 + c4);
                    u32x2 w; w.x = cvtpk(v[0], v[1]); w.y = cvtpk(v[2], v[3]); *(u32x2*)(F.WU + (size_t)(k0 + kk) * 2048 + j * 1024 + n0 + c4) = w; } }
            continue; } r -= 2 * I_PIN;
        if (r < 8 * I_GRP) { const int j = r / I_GRP; p0_transpose_item<0>(F.pool_w_grp + (size_t)j * 65536, 256, 256, F.WGRP + (size_t)j * 65536, scr, r % I_GRP, F.lane); continue; } r -= 8 * I_GRP;
        if (r < 2 * I_SQ) { const int j = r / I_SQ; p0_transpose_item<0>(F.pool_w_out + (size_t)j * 1024 * 1024, 1024, 1024, F.WPOUT + (size_t)j * 1024 * 1024, scr, r % I_SQ, F.lane); continue; } r -= 2 * I_SQ;
        if (r < I_BIG) { p0_transpose_item<0>(F.na_w_in, 1024, 4096, F.WNIN, scr, r, F.lane); continue; } r -= I_BIG;
        if (r < I_SQ) { p0_transpose_item<0>(F.na_w_out, 1024, 1024, F.WNOUT, scr, r, F.lane); continue; } r -= I_SQ;
        if (r < I_BIG) { p0_transpose_item<1>(F.conv_w_in, 1024, 4096, F.WCIN, scr, r, F.lane); continue; } r -= I_BIG;
        p0_transpose_item<0>(F.conv_w_out, 1024, 1024, F.WCOUT, scr, r, F.lane);
    }
}
__device__ __forceinline__ void unpack8(const u32x4 w, float (&f)[8]) { f[0] = bflo(w.x); f[1] = bfhi(w.x); f[2] = bflo(w.y); f[3] = bfhi(w.y); f[4] = bflo(w.z); f[5] = bfhi(w.z); f[6] = bflo(w.w); f[7] = bfhi(w.w); }
__device__ __forceinline__ void p1_prep(Frame& F) {
    const int gw = F.vcu * NWAVES + F.wave, lane = F.lane;
    {
        LAS float* sh = (LAS float*)F.lds;
        int staged = -1;
        const int per = ((12288 + F.G - 1) / F.G + 7) & ~7;
        for (int st = 0; st < per / 8; ++st) {
            const int task0 = F.vcu * per + st * 8, task = task0 + F.wave;
            if (task0 >= 12288) break;
            const int L = task0 < 2048 ? 0 : task0 < 6144 ? 1 : task0 < 10240 ? 2 : 3;
            if (staged != L) { __syncthreads();
                for (int e = F.tid; e < 9 * 1024; e += NWAVES * 64) sh[e] = F.MOD[(size_t)(L * 9 + (e >> 10)) * 3072 + (e & 1023)];
                __syncthreads(); staged = L; }
            const int n = task - (L == 0 ? 0 : L == 1 ? 2048 : L == 2 ? 6144 : 10240);
            const bf16_t* WT = L == 0 ? F.WPIN : L == 1 ? F.WNIN : L == 2 ? F.WCIN : F.WPIN + (size_t)2048 * 1024;
            const u32x4 w0 = *(const u32x4*)(WT + (size_t)n * 1024 + lane * 8), w1 = *(const u32x4*)(WT + (size_t)n * 1024 + 512 + lane * 8);
            float wa[8], wb[8]; unpack8(w0, wa); unpack8(w1, wb);
            float d[9];
#pragma unroll
            for (int b = 0; b < 9; ++b) { const LAS f32x4* sp = (const LAS f32x4*)(sh + b * 1024 + lane * 8); const f32x4 s0 = sp[0], s1 = sp[1], s2 = sp[128], s3 = sp[129];
                float a = 0.f;
#pragma unroll
                for (int j = 0; j < 4; ++j) a += s0[j] * wa[j] + s1[j] * wa[4 + j] + s2[j] * wb[j] + s3[j] * wb[4 + j];
                d[b] = a; }
#pragma unroll
            for (int b = 0; b < 9; ++b) d[b] = wave_sum(d[b]);
            if (lane < 9) { float v = d[0];
#pragma unroll
                for (int b = 1; b < 9; ++b) v = lane == b ? d[b] : v;
                F.CVEC[(size_t)(L * 9 + lane) * 4096 + n] = v; }
        }
        __syncthreads();
    }
}
__device__ __forceinline__ void p_rows(Frame& F) {
    const int gw = F.vcu * NWAVES + F.wave, lane = F.lane;
    {
        const int rpw = (MT + F.G * NWAVES - 1) / (F.G * NWAVES);
        const int rbeg = gw * rpw, rend = min(rbeg + rpw, MT);
        int bmc = -1; f32x4 a[4];
        for (int r = rbeg; r < rend; r += 3) {
            f32x4 v[3][4];
#pragma unroll
            for (int q = 0; q < 3; ++q) { const int row = min(r + q, MT - 1); const float* src = row < MX ? F.x + (size_t)row * 1024 : F.ctx + (size_t)(row - MX) * 1024;
#pragma unroll
                for (int j = 0; j < 4; ++j) v[q][j] = *(const f32x4*)(src + 256 * j + 4 * lane); }
#pragma unroll
            for (int q = 0; q < 3; ++q) { const int row = r + q; if (row < rend) {
                const int bm = row < MX ? (row >> 11) : 8;
                if (bm != bmc) { const float* scl = F.MOD + (size_t)bm * 3072 + 1024;
#pragma unroll
                    for (int j = 0; j < 4; ++j) a[j] = *(const f32x4*)(F.norm_g + 256 * j + 4 * lane) * (*(const f32x4*)(scl + 256 * j + 4 * lane) + 1.0f);
                    bmc = bm; }
                float ss = 0.f;
#pragma unroll
                for (int j = 0; j < 4; ++j) ss += (v[q][j].x * v[q][j].x + v[q][j].y * v[q][j].y) + (v[q][j].z * v[q][j].z + v[q][j].w * v[q][j].w);
                ss = wave_sum(ss);
                if (lane < 16) F.SSQ[(size_t)row * 16 + lane] = lane == 0 ? ss : 0.f;
#pragma unroll
                for (int j = 0; j < 4; ++j) { const f32x4 t = v[q][j] * a[j]; u32x2 w; w.x = cvtpk(t[0], t[1]); w.y = cvtpk(t[2], t[3]); *(u32x2*)(F.XT + (size_t)row * 1024 + 256 * j + 4 * lane) = w; } } }
        }
    }
}
__device__ __forceinline__ void e_pool(Frame& F, const bf16_t* U, const bf16_t* SGb, bf16_t* A2, int nrows) {
    const int ntiles = (nrows / 32) * 2;
    const int lane = F.lane, wave = F.wave;
#define EP_GEOM(tile) const int ch_ = (tile) & 1, r0_ = ((tile) >> 1) * 32; \
        const int seq0_ = r0_ < MX ? (r0_ & ~(SEQ - 1)) : MX + ((r0_ - MX) & ~(CTXL - 1)); const int L_ = r0_ < MX ? SEQ : CTXL; const int t0_ = r0_ - seq0_;
#define EP_DMA(tile, bsel) do { EP_GEOM(tile) \
        _Pragma("unroll") for (int i_ = 0; i_ < 6; ++i_) { const int lr_ = wave + 8 * i_; const int t_ = min(max(t0_ - 8 + lr_, 0), L_ - 1); \
            __builtin_amdgcn_global_load_lds((const unsigned*)(U + (size_t)(seq0_ + t_) * 1024 + ch_ * 512 + lane * 8), (LAS unsigned*)(F.lds + (bsel) * 49152 + lr_ * 1024), 16, 0, 0); } } while (0)
    int tile = F.vcu, k = 0;
    if (tile < ntiles) EP_DMA(tile, 0);
    for (; tile < ntiles; tile += F.G, k ^= 1) {
        asm volatile("s_waitcnt vmcnt(0) lgkmcnt(0)" ::: "memory");
        __builtin_amdgcn_s_barrier();
        asm volatile("" ::: "memory");
        if (tile + F.G < ntiles) EP_DMA(tile + F.G, k ^ 1);
        EP_GEOM(tile)
        const int col = ch_ * 512 + lane * 8, hw = 1 << (col >> 8);
        const LAS unsigned char* img = F.lds + k * 49152 + lane * 16;
        const int tf = t0_ + 4 * wave;
        float S[8];
#pragma unroll
        for (int j = 0; j < 8; ++j) S[j] = 0.f;
        { const int lo = max(tf - hw, 0), hi = min(tf + hw, L_);
          for (int t = lo; t < hi; ++t) { float f[8]; unpack8(*(const LAS u32x4*)(img + (t - t0_ + 8) * 1024), f);
#pragma unroll
              for (int j = 0; j < 8; ++j) S[j] += f[j]; } }
#pragma unroll
        for (int i = 0; i < 4; ++i) { const int t = tf + i; const int lo = max(t - hw, 0), hi = min(t + hw, L_); const float inv = 1.0f / (float)(hi - lo);
            float f[8]; unpack8(*(const LAS u32x4*)(img + (t - t0_ + 8) * 1024), f);
            float sg[8]; unpack8(*(const u32x4*)(SGb + (size_t)(seq0_ + t) * 1024 + col), sg);
            f32x4 o0, o1;
#pragma unroll
            for (int j = 0; j < 4; ++j) { o0[j] = (S[j] * inv - f[j]) * sg[j]; o1[j] = (S[4 + j] * inv - f[4 + j]) * sg[4 + j]; }
            *(u32x4*)(A2 + (size_t)(seq0_ + t) * 1024 + col) = pg8::pack8(o0, o1);
            if (i < 3) {
                if (t + hw < L_) { float a[8]; unpack8(*(const LAS u32x4*)(img + (t + hw - t0_ + 8) * 1024), a);
#pragma unroll
                    for (int j = 0; j < 8; ++j) S[j] += a[j]; }
                if (t - hw >= 0) { float a[8]; unpack8(*(const LAS u32x4*)(img + (t - hw - t0_ + 8) * 1024), a);
#pragma unroll
                    for (int j = 0; j < 8; ++j) S[j] -= a[j]; } } }
    }
    asm volatile("s_waitcnt vmcnt(0) lgkmcnt(0)" ::: "memory");
    __builtin_amdgcn_s_barrier();
#undef EP_DMA
#undef EP_GEOM
}
__device__ __forceinline__ void e_conv(Frame& F, const bf16_t* P, const bf16_t* Sg, bf16_t* Z) {
    const int gt = F.vcu * (NWAVES * 64) + F.tid, NT = F.G * NWAVES * 64;
    const int nitems = (MX / 16) * 128;
    for (int id = gt; id < nitems; id += NT) {
        const int col = (id & 127) * 8, r0 = (id >> 7) * 16, t0 = r0 & (SEQ - 1);
        float w0[8], w1[8], w2[8], bb[8];
#pragma unroll
        for (int h = 0; h < 2; ++h) { const f32x4 a = *(const f32x4*)(F.conv_dw + col + 4 * h), b = *(const f32x4*)(F.conv_dw + 1024 + col + 4 * h), c = *(const f32x4*)(F.conv_dw + 2048 + col + 4 * h), d = *(const f32x4*)(F.conv_db + col + 4 * h);
#pragma unroll
            for (int j = 0; j < 4; ++j) { w0[4 * h + j] = a[j]; w1[4 * h + j] = b[j]; w2[4 * h + j] = c[j]; bb[4 * h + j] = d[j]; } }
        float prev[8], cur[8], nxt[8];
        if (t0 > 0) unpack8(*(const u32x4*)(P + (size_t)(r0 - 1) * 1024 + col), prev); else {
#pragma unroll
            for (int j = 0; j < 8; ++j) prev[j] = 0.f; }
        unpack8(*(const u32x4*)(P + (size_t)r0 * 1024 + col), cur);
        for (int i = 0; i < 16; ++i) { const int t = t0 + i;
            if (t + 1 < SEQ) unpack8(*(const u32x4*)(P + (size_t)(r0 + i + 1) * 1024 + col), nxt); else {
#pragma unroll
                for (int j = 0; j < 8; ++j) nxt[j] = 0.f; }
            float s[8]; unpack8(*(const u32x4*)(Sg + (size_t)(r0 + i) * 1024 + col), s);
            f32x4 o0, o1;
#pragma unroll
            for (int j = 0; j < 4; ++j) { o0[j] = s[j] * (w0[j] * prev[j] + w1[j] * cur[j] + w2[j] * nxt[j] + bb[j]); o1[j] = s[4 + j] * (w0[4 + j] * prev[4 + j] + w1[4 + j] * cur[4 + j] + w2[4 + j] * nxt[4 + j] + bb[4 + j]); }
            *(u32x4*)(Z + (size_t)(r0 + i) * 1024 + col) = pg8::pack8(o0, o1);
#pragma unroll
            for (int j = 0; j < 8; ++j) { prev[j] = cur[j]; cur[j] = nxt[j]; } }
    }
}
__device__ __forceinline__ void e_final(Frame& F) {
    const int gw = F.vcu * NWAVES + F.wave, NGW = F.G * NWAVES, lane = F.lane;
    for (int row = gw; row < MX; row += NGW) {
        const float rs = pg8::row_rstd(F.SSQ, row);
#pragma unroll
        for (int j = 0; j < 4; ++j) { float* p = F.out + (size_t)row * 1024 + 256 * j + 4 * lane; const f32x4 v = *(const f32x4*)p; const f32x4 g = *(const f32x4*)(F.final_g + 256 * j + 4 * lane); *(f32x4*)p = v * rs * g; }
    }
}
__device__ __forceinline__ void attn_naive(Frame& F, const bf16_t* Q, const bf16_t* Kb, const bf16_t* Vb, const bf16_t* SGb, bf16_t* Z) {
    const int gw = F.vcu * NWAVES + F.wave, NGW = F.G * NWAVES, lane = F.lane;
    for (int task = gw; task < MX * 16; task += NGW) {
        const int tok = task >> 4, h = task & 15;
        const int b = tok >> 11, pos = tok & 2047, r = pos >> 6, col = pos & 63;
        const int rs = min(max(r - 4, 0), 24), cs = min(max(col - 8, 0), 48);
        const bf16_t* qp = Q + (size_t)tok * 1024 + h * 64;
        float s[6]; int kt[6];
#pragma unroll
        for (int t = 0; t < 6; ++t) {
            float bias = 0.f; int ktok;
            if (t < 2) { const int kk = lane + 64 * t, i = kk >> 4, jj = kk & 15; ktok = b * 2048 + (rs + i) * 64 + cs + jj;
                bias = F.na_rpb[(h * 15 + (rs + i - r + 7)) * 31 + (cs + jj - col + 15)] * LOG2E; }
            else { ktok = MX + b * 256 + lane + 64 * (t - 2); }
            kt[t] = ktok;
            const bf16_t* kp = Kb + (size_t)ktok * 1024 + h * 64; float d = 0.f;
#pragma unroll
            for (int d8 = 0; d8 < 8; ++d8) { float qf[8], kf[8]; unpack8(*(const u32x4*)(qp + d8 * 8), qf); unpack8(*(const u32x4*)(kp + d8 * 8), kf);
#pragma unroll
                for (int j = 0; j < 8; ++j) d += qf[j] * kf[j]; }
            s[t] = d + bias;
        }
        float m = s[0];
#pragma unroll
        for (int t = 1; t < 6; ++t) m = fmaxf(m, s[t]);
        m = wave_max(m);
        float l = 0.f;
#pragma unroll
        for (int t = 0; t < 6; ++t) { s[t] = __builtin_amdgcn_exp2f(s[t] - m); l += s[t]; }
        l = wave_sum(l);
        float o = 0.f;
#pragma unroll
        for (int t = 0; t < 6; ++t)
            for (int src = 0; src < 64; ++src) { const float pv = __shfl(s[t], src); const int ktok = __shfl(kt[t], src);
                const float v = bflo((unsigned)Vb[(size_t)ktok * 1024 + h * 64 + lane]); o += pv * v; }
        const float sg = bflo((unsigned)SGb[(size_t)tok * 1024 + h * 64 + lane]);
        const float z = o / l * sg;
        Z[(size_t)tok * 1024 + h * 64 + lane] = (bf16_t)(cvtpk(z, 0.f) & 0xffffu);
    }
}


namespace att {
using f32x16 = __attribute__((ext_vector_type(16))) float;
using s16x4 = __attribute__((ext_vector_type(4))) short;
typedef short v4i16_t __attribute__((ext_vector_type(4)));
typedef LAS const char* lds_cptr;
constexpr int L_K = 0, L_V = 16384, L_TAB = 32768, L_WS = 36864, L_OST = 40960;
constexpr float NEG = -1e30f;
constexpr float THR = 8.0f;
__device__ __forceinline__ int crow(int r, int hi) { return (r & 3) + 8 * (r >> 2) + 4 * hi; }
__device__ __forceinline__ s16x4 vtr(lds_cptr p) { return __builtin_bit_cast(s16x4, __builtin_amdgcn_ds_read_tr16_b64_v4i16((LAS v4i16_t*)p)); }
__device__ __forceinline__ float half_max(float m) { auto rr = __builtin_amdgcn_permlane32_swap(__float_as_uint(m), __float_as_uint(m), false, false); return fmaxf(__uint_as_float(rr[0]), __uint_as_float(rr[1])); }
__device__ __forceinline__ float half_sum(float m) { auto rr = __builtin_amdgcn_permlane32_swap(__float_as_uint(m), __float_as_uint(m), false, false); return __uint_as_float(rr[0]) + __uint_as_float(rr[1]); }

__device__ __forceinline__ void attn_unit(LAS unsigned char* lds, int b, int h, int r0, const bf16_t* Q, const bf16_t* Kb, const bf16_t* Vb, const bf16_t* SGb, bf16_t* Z, const float* rpb, int tid, int wid, int lane) {
    const int r32 = lane & 31, hi = lane >> 5;
    const int rq = r0 + (wid >> 1), colq = 32 * (wid & 1) + r32;
    const int rsw = min(max(rq - 4, 0), 24);
    const int kr_lo = min(max(r0 - 4, 0), 24), kr_hi = min(max(r0 + 3 - 4, 0), 24) + 7;
    const int NL = kr_hi - kr_lo + 1, NT = NL + 4;
    if (tid < 480) { const int row = tid >> 5, ci = tid & 31; ((LAS float*)(lds + L_TAB))[tid] = ci < 31 ? rpb[(h * 15 + row) * 31 + ci] * LOG2E : NEG; }
    unsigned boffp[8];
    { const int cs = min(max(colq - 8, 0), 48);
#pragma unroll
      for (int g = 0; g < 8; ++g) { unsigned pk = 0;
#pragma unroll
          for (int j = 0; j < 4; ++j) { const int r = (g & 3) * 4 + j; const int kc = crow(r, hi) + 32 * (g >> 2); const bool valid = (unsigned)(kc - cs) < 16u; const unsigned o = valid ? (unsigned)(kc - colq + 15) * 4u : 124u; pk |= o << (8 * j); }
          boffp[g] = pk; } }
    const size_t qtok = (size_t)b * SEQ + rq * 64 + colq;
    bf16x8 qr[4];
#pragma unroll
    for (int d0 = 0; d0 < 4; ++d0) qr[d0] = *(const bf16x8*)(Q + qtok * 1024 + h * 64 + d0 * 16 + hi * 8);
    const bf16_t* ksrc = Kb + (size_t)lane * 1024 + h * 64 + wid * 8;
    const bf16_t* vsrc = Vb + (size_t)(16 * (wid & 3) + (lane >> 2)) * 1024 + h * 64 + (wid >> 2) * 32 + (lane & 3) * 8;
#define ATT_TOK(t) ((t) < NL ? (size_t)b * SEQ + (size_t)(kr_lo + (t)) * 64 : (size_t)MX + (size_t)b * CTXL + (size_t)((t) - NL) * 64)
#define ATT_DMA(t) do { const size_t tk_ = ATT_TOK(t) * 1024; const int bo_ = ((t) & 1) * 8192; \
        __builtin_amdgcn_global_load_lds((const unsigned*)(ksrc + tk_), (LAS unsigned*)(lds + L_K + bo_ + wid * 1024), 16, 0, 0); \
        __builtin_amdgcn_global_load_lds((const unsigned*)(vsrc + tk_), (LAS unsigned*)(lds + L_V + bo_ + wid * 1024), 16, 0, 0); } while (0)
    ATT_DMA(0);
    f32x16 o0, o1;
#pragma unroll
    for (int r = 0; r < 16; ++r) { o0[r] = 0.f; o1[r] = 0.f; }
    float mref = NEG, lsum = 0.f;
    LAS float* wsf = (LAS float*)(lds + L_WS) + wid * 64;
    const lds_cptr kp0 = (lds_cptr)(lds + L_K) + hi * 1024 + r32 * 16;
    const lds_cptr vp0 = (lds_cptr)(lds + L_V) + ((lane >> 4) & 1) * 32 + (lane & 3) * 8 + (4 * hi + ((lane & 15) >> 2)) * 64;
    for (int t = 0; t < NT; ++t) {
        asm volatile("s_waitcnt vmcnt(0) lgkmcnt(0)" ::: "memory");
        __builtin_amdgcn_s_barrier();
        asm volatile("" ::: "memory");
        if (t + 1 < NT) ATT_DMA(t + 1);
        const bool local = t < NL; const int kr = kr_lo + t;
        const bool active = !local || (kr >= rsw && kr < rsw + 8);
        if (active) {
            const int bo = (t & 1) * 8192;
            f32x16 p0, p1;
#pragma unroll
            for (int r = 0; r < 16; ++r) { p0[r] = 0.f; p1[r] = 0.f; }
            { const lds_cptr kb = kp0 + bo;
#pragma unroll
              for (int d0 = 0; d0 < 4; ++d0) { const bf16x8 a0 = *(const LAS bf16x8*)(kb + d0 * 2048), a1 = *(const LAS bf16x8*)(kb + d0 * 2048 + 512);
                  p0 = __builtin_amdgcn_mfma_f32_32x32x16_bf16(a0, qr[d0], p0, 0, 0, 0); p1 = __builtin_amdgcn_mfma_f32_32x32x16_bf16(a1, qr[d0], p1, 0, 0, 0); } }
            if (local) { const lds_cptr tb = (lds_cptr)(lds + L_TAB) + (kr - rq + 7) * 128;
#pragma unroll
                for (int r = 0; r < 16; ++r) { p0[r] += *(const LAS float*)(tb + ((boffp[r >> 2] >> (8 * (r & 3))) & 0xffu)); p1[r] += *(const LAS float*)(tb + ((boffp[4 + (r >> 2)] >> (8 * (r & 3))) & 0xffu)); } }
            float mt = fmaxf(p0[0], p1[0]);
#pragma unroll
            for (int r = 1; r < 16; ++r) mt = fmaxf(mt, fmaxf(p0[r], p1[r]));
            mt = half_max(mt);
            if (__any(mt > mref + THR)) {
                const float mnew = fmaxf(mref, mt), alpha = __builtin_amdgcn_exp2f(mref - mnew);
                lsum *= alpha; mref = mnew;
                if (hi == 0) wsf[r32] = alpha;
                asm volatile("s_waitcnt lgkmcnt(0)" ::: "memory");
#pragma unroll
                for (int r = 0; r < 16; ++r) { const float f = wsf[crow(r, hi)]; o0[r] *= f; o1[r] *= f; }
            }
            float sacc = 0.f;
#pragma unroll
            for (int r = 0; r < 16; ++r) { p0[r] = __builtin_amdgcn_exp2f(p0[r] - mref); p1[r] = __builtin_amdgcn_exp2f(p1[r] - mref); sacc += p0[r] + p1[r]; }
            lsum += sacc;
            u32x4 pw0, pw1, pw2, pw3;
            pw0 = (u32x4){cvtpk(p0[0], p0[1]), cvtpk(p0[2], p0[3]), cvtpk(p0[4], p0[5]), cvtpk(p0[6], p0[7])};
            pw1 = (u32x4){cvtpk(p0[8], p0[9]), cvtpk(p0[10], p0[11]), cvtpk(p0[12], p0[13]), cvtpk(p0[14], p0[15])};
            pw2 = (u32x4){cvtpk(p1[0], p1[1]), cvtpk(p1[2], p1[3]), cvtpk(p1[4], p1[5]), cvtpk(p1[6], p1[7])};
            pw3 = (u32x4){cvtpk(p1[8], p1[9]), cvtpk(p1[10], p1[11]), cvtpk(p1[12], p1[13]), cvtpk(p1[14], p1[15])};
            const lds_cptr vp = vp0 + bo;
#define ATT_VF(i) ({ const s16x4 lo_ = vtr(vp + (((i) >> 2) * 4096 + ((i) & 3) * 1024)); const s16x4 hi_ = vtr(vp + (((i) >> 2) * 4096 + ((i) & 3) * 1024 + 512)); (bf16x8){lo_[0], lo_[1], lo_[2], lo_[3], hi_[0], hi_[1], hi_[2], hi_[3]}; })
            o0 = __builtin_amdgcn_mfma_f32_32x32x16_bf16(__builtin_bit_cast(bf16x8, pw0), ATT_VF(0), o0, 0, 0, 0);
            o1 = __builtin_amdgcn_mfma_f32_32x32x16_bf16(__builtin_bit_cast(bf16x8, pw0), ATT_VF(4), o1, 0, 0, 0);
            o0 = __builtin_amdgcn_mfma_f32_32x32x16_bf16(__builtin_bit_cast(bf16x8, pw1), ATT_VF(1), o0, 0, 0, 0);
            o1 = __builtin_amdgcn_mfma_f32_32x32x16_bf16(__builtin_bit_cast(bf16x8, pw1), ATT_VF(5), o1, 0, 0, 0);
            o0 = __builtin_amdgcn_mfma_f32_32x32x16_bf16(__builtin_bit_cast(bf16x8, pw2), ATT_VF(2), o0, 0, 0, 0);
            o1 = __builtin_amdgcn_mfma_f32_32x32x16_bf16(__builtin_bit_cast(bf16x8, pw2), ATT_VF(6), o1, 0, 0, 0);
            o0 = __builtin_amdgcn_mfma_f32_32x32x16_bf16(__builtin_bit_cast(bf16x8, pw3), ATT_VF(3), o0, 0, 0, 0);
            o1 = __builtin_amdgcn_mfma_f32_32x32x16_bf16(__builtin_bit_cast(bf16x8, pw3), ATT_VF(7), o1, 0, 0, 0);
#undef ATT_VF
        }
    }
#undef ATT_DMA
#undef ATT_TOK
    lsum = half_sum(lsum);
    if (hi == 0) wsf[32 + r32] = lsum;
    asm volatile("s_waitcnt lgkmcnt(0)" ::: "memory");
    LAS bf16_t* st = (LAS bf16_t*)(lds + L_OST) + wid * 2048;
#pragma unroll
    for (int r = 0; r < 16; ++r) { const int orow = crow(r, hi); const float rl = __builtin_amdgcn_rcpf(wsf[32 + orow]);
        st[orow * 64 + r32] = (bf16_t)(cvtpk(o0[r] * rl, 0.f) & 0xffffu); st[orow * 64 + 32 + r32] = (bf16_t)(cvtpk(o1[r] * rl, 0.f) & 0xffffu); }
    asm volatile("s_waitcnt lgkmcnt(0)" ::: "memory");
    const size_t tok0 = (size_t)b * SEQ + rq * 64 + 32 * (wid & 1);
#pragma unroll
    for (int i = 0; i < 4; ++i) { const int row = i * 8 + (lane >> 3), chn = lane & 7;
        const u32x4 v = *(const LAS u32x4*)(st + row * 64 + chn * 8); const size_t off = (tok0 + row) * 1024 + h * 64 + chn * 8;
        const u32x4 s = *(const u32x4*)(SGb + off);
        f32x4 a0, a1; a0[0] = bflo(v.x) * bflo(s.x); a0[1] = bfhi(v.x) * bfhi(s.x); a0[2] = bflo(v.y) * bflo(s.y); a0[3] = bfhi(v.y) * bfhi(s.y);
        a1[0] = bflo(v.z) * bflo(s.z); a1[1] = bfhi(v.z) * bfhi(s.z); a1[2] = bflo(v.w) * bflo(s.w); a1[3] = bfhi(v.w) * bfhi(s.w);
        *(u32x4*)(Z + off) = pg8::pack8(a0, a1); }
    asm volatile("s_waitcnt vmcnt(0) lgkmcnt(0)" ::: "memory");
    __builtin_amdgcn_s_barrier();
    asm volatile("" ::: "memory");
}
}
__device__ __forceinline__ void attn_mfma(Frame& F, const bf16_t* Q, const bf16_t* Kb, const bf16_t* Vb, const bf16_t* SGb, bf16_t* Z) {
    const int NU = NB * 16 * 8;
    const int per = (NU + F.G - 1) / F.G;
    for (int i = 0; i < per; ++i) { const int u = F.vcu * per + i; if (u >= NU) break;
        const int bh = u >> 3, rq4 = u & 7;
        att::attn_unit(F.lds, bh >> 4, bh & 15, rq4 * 4, Q, Kb, Vb, SGb, Z, F.na_rpb, F.tid, F.wave, F.lane); }
}

constexpr int NPHASE = 16;
__global__ void __launch_bounds__(NWAVES * 64, 2) fwd_mega(Args args) {
    extern __shared__ __attribute__((aligned(16))) unsigned char lds[];
    Frame F;
    F.lds = (LAS unsigned char*)lds;
    F.MISC = (volatile LAS unsigned*)(F.lds + MISC_OFF);
    F.tid = threadIdx.x; F.lane = F.tid & 63; F.wave = __builtin_amdgcn_readfirstlane(F.tid >> 6);
    F.G = gridDim.x; { const int bx = blockIdx.x; F.vcu = (F.G % 8 == 0) ? (bx % 8) * (F.G / 8) + bx / 8 : bx; }
    F.x = args.in[0]; F.c = args.in[1]; F.ctx = args.in[2]; F.c_ctx = args.in[3]; F.norm_g = args.in[4]; F.ada_w = args.in[5]; F.ada_b = args.in[6];
    F.pool_w_in = args.in[7]; F.pool_w_grp = args.in[8]; F.pool_scale = args.in[9]; F.pool_w_out = args.in[10]; F.na_w_in = args.in[11]; F.na_rpb = args.in[12]; F.na_w_out = args.in[13];
    F.conv_w_in = args.in[14]; F.conv_dw = args.in[15]; F.conv_db = args.in[16]; F.conv_w_out = args.in[17]; F.final_g = args.in[18];
    F.out = args.out; F.ws = args.ws;
    unsigned char* ws = args.ws;
    F.MOD = (float*)(ws + WS_MOD); F.CVEC = (float*)(ws + WS_CVEC); F.SSQ = (float*)(ws + WS_SSQ); F.XC = (float*)(ws + WS_XC);
    F.WPIN = (bf16_t*)(ws + WS_WPIN); F.WGRP = (bf16_t*)(ws + WS_WGRP); F.WPOUT = (bf16_t*)(ws + WS_WPOUT); F.WNIN = (bf16_t*)(ws + WS_WNIN); F.WNOUT = (bf16_t*)(ws + WS_WNOUT);
    F.WCIN = (bf16_t*)(ws + WS_WCIN); F.WCOUT = (bf16_t*)(ws + WS_WCOUT); F.XT = (bf16_t*)(ws + WS_XT); F.ACT0 = (bf16_t*)(ws + WS_ACT0); F.WU = (bf16_t*)(ws + WS_WU);
    constexpr size_t AS = ACT_STRIDE / 2;
    bf16_t* const A0 = F.ACT0; bf16_t* const A1 = F.ACT0 + AS; bf16_t* const A2 = F.ACT0 + 2 * AS; bf16_t* const A3 = F.ACT0 + 3 * AS;

    for (int u = F.tid; u < (LDS_BYTES - LDSCTL_OFF) / 4; u += NWAVES * 64) ((LAS unsigned*)(F.lds + LDSCTL_OFF))[u] = 0u;
    __syncthreads();
    unsigned* barw = (unsigned*)(ws + WS_CTL) + CW_BAR;
    XcdBarrier bar; bar.bar = barw; bar.x = 0; bar.st = nullptr;
    if (!MK_PER_PHASE) bar = xcd_barrier_post(barw, F.MISC + 8);
    const int lo = args.ph_lo, hi = args.ph_hi;
#define IN(k) (lo <= (k) && (k) < hi)
#define SEAM(k) do { if (IN(k) && IN((k) + 1)) xcd_barrier(bar); } while (0)
    typedef pg8::StaticOrder SO;
    const int bid = (int)blockIdx.x;

#define REPEAT(PH, ...) do { __VA_ARGS__ if (MK_REP == (PH)) { xcd_barrier(bar); __VA_ARGS__ } } while (0)
    if (IN(0)) { REPEAT(0, { p0_prologue(F); }); } SEAM(0);
    if (IN(1)) { REPEAT(1, { { pg8::Gemm g{F.WGRP, F.WU, 2048, 1024, 256, 256, 2048, 256}; SO S; S.init(2048, 1024, F.G, bid);
          pg8::EpiFold E{F.WPIN};
          pg8::gemm_phase<pg8::EpiFold, SO>(F.lds, g, S, E); }
        p_rows(F); }); } SEAM(1);
    if (IN(2)) { REPEAT(2, { p1_prep(F); }); } SEAM(2);

#define POOL_LAYER(PH, LI, PJ, MROWS) \
    if (IN(PH)) { REPEAT(PH, { pg8::Gemm g{F.XT, F.WPIN + (size_t)(PJ) * 2048 * 1024, (MROWS), 2048, 1024, 1024, 1024, 0}; SO S; S.init((MROWS), 2048, F.G, bid); \
        pg8::EpiPool1 E{F.SSQ, F.CVEC + (size_t)(LI) * 9 * 4096, F.pool_scale + (PJ) * 1024, A0, A1}; \
        pg8::gemm_phase<pg8::EpiPool1, SO>(F.lds, g, S, E); }); } SEAM(PH); \
    if (IN((PH) + 1)) { REPEAT((PH) + 1, { e_pool(F, A0, A1, A2, (MROWS)); }); } SEAM((PH) + 1);

    POOL_LAYER(3, 0, 0, MT)
    if (IN(5)) { REPEAT(5, { pg8::Gemm g{A2, F.WPOUT, MT, 1024, 1024, 1024, 1024, 0}; SO S; S.init(MT, 1024, F.G, bid);
        pg8::EpiOut E{F.x, F.ctx, F.out, F.XC, F.MOD + 0 * 9 * 3072 + 2048, F.norm_g + 1024, F.MOD + 1 * 9 * 3072 + 1024, F.XT, F.SSQ};
        pg8::gemm_phase<pg8::EpiOut, SO>(F.lds, g, S, E); }); } SEAM(5);

    if (IN(6)) { REPEAT(6, {
        { pg8::Gemm g{F.XT, F.WNIN, MX, 4096, 1024, 1024, 1024, 0}; SO S; S.init(MX, 4096, F.G, bid);
          pg8::EpiNa1 E{F.SSQ, F.CVEC + (size_t)1 * 9 * 4096, A0, AS, 0, -1};
          pg8::gemm_phase<pg8::EpiNa1, SO>(F.lds, g, S, E); }
        { pg8::Gemm g{F.XT + (size_t)MX * 1024, F.WNIN + (size_t)1024 * 1024, MC, 2048, 1024, 1024, 1024, 0}; SO S; S.init(MC, 2048, F.G, (bid + 128) % F.G);
          pg8::EpiNa1 E{F.SSQ + (size_t)MX * 16, F.CVEC + (size_t)1 * 9 * 4096 + 1024, A0 + (size_t)MX * 1024, AS, 1, 8};
          pg8::gemm_phase<pg8::EpiNa1, SO>(F.lds, g, S, E); }
    }); } SEAM(6);
#if MK_NAIVE_ATTN
    if (IN(7)) { attn_naive(F, A0, A1, A2, A3, A0); } SEAM(7);
#else
    if (IN(7)) { if (MK_REP == 7) { attn_mfma(F, A0, A1, A2, A3, F.XT); xcd_barrier(bar); } attn_mfma(F, A0, A1, A2, A3, A0); } SEAM(7);
#endif
    if (IN(8)) { pg8::Gemm g{A0, F.WNOUT, MX, 1024, 1024, 1024, 1024, 0}; SO S; S.init(MX, 1024, F.G, bid);
        pg8::EpiOut E{F.out, F.XC, F.out, F.XC, F.MOD + 1 * 9 * 3072 + 2048, F.norm_g + 2048, F.MOD + 2 * 9 * 3072 + 1024, F.XT, F.SSQ};
        pg8::gemm_phase<pg8::EpiOut, SO>(F.lds, g, S, E); } SEAM(8);

    if (IN(9)) { REPEAT(9, { pg8::Gemm g{F.XT, F.WCIN, MX, 4096, 1024, 1024, 1024, 0}; SO S; S.init(MX, 4096, F.G, bid);
        pg8::EpiConv1 E{F.SSQ, F.CVEC + (size_t)2 * 9 * 4096, A0, A1};
        pg8::gemm_phase<pg8::EpiConv1, SO>(F.lds, g, S, E); }); } SEAM(9);
    if (IN(10)) { REPEAT(10, { e_conv(F, A0, A1, A2); }); } SEAM(10);
    if (IN(11)) { pg8::Gemm g{A2, F.WCOUT, MX, 1024, 1024, 1024, 1024, 0}; SO S; S.init(MX, 1024, F.G, bid);
        pg8::EpiOut E{F.out, F.XC, F.out, F.XC, F.MOD + 2 * 9 * 3072 + 2048, F.norm_g + 3072, F.MOD + 3 * 9 * 3072 + 1024, F.XT, F.SSQ};
        pg8::gemm_phase<pg8::EpiOut, SO>(F.lds, g, S, E); } SEAM(11);

    POOL_LAYER(12, 3, 1, MX)
    if (IN(14)) { pg8::Gemm g{A2, F.WPOUT + (size_t)1024 * 1024, MX, 1024, 1024, 1024, 1024, 0}; SO S; S.init(MX, 1024, F.G, bid);
        pg8::EpiOut E{F.out, F.XC, F.out, F.XC, F.MOD + 3 * 9 * 3072 + 2048, nullptr, nullptr, F.XT, F.SSQ};
        pg8::gemm_phase<pg8::EpiOut, SO>(F.lds, g, S, E); } SEAM(14);
    if (IN(15)) { e_final(F); }
#undef IN
#undef SEAM
}

extern "C" void kernel_launch(void* const* d_in, const int* in_sizes, int n_in, void* d_out, int out_size, void* d_ws, size_t ws_size, hipStream_t stream) {
    static int grid = 0;
    if (grid == 0) {
        if (n_in != 19 || out_size != MX * DM || ws_size < WS_END) { fprintf(stderr, "kernel_launch: unexpected shapes (n_in %d, out %d, ws %zu); nothing launched\n", n_in, out_size, ws_size); grid = -1; return; }
        int dev = 0, cus = 0, per_cu = 0;
        if (hipGetDevice(&dev) != hipSuccess || hipDeviceGetAttribute(&cus, hipDeviceAttributeMultiprocessorCount, dev) != hipSuccess) { grid = -1; return; }
        if (hipFuncSetAttribute((const void*)fwd_mega, hipFuncAttributeMaxDynamicSharedMemorySize, LDS_BYTES) != hipSuccess) { fprintf(stderr, "kernel_launch: hipFuncSetAttribute failed\n"); grid = -1; return; }
        if (hipOccupancyMaxActiveBlocksPerMultiprocessor(&per_cu, (const void*)fwd_mega, NWAVES * 64, LDS_BYTES) != hipSuccess || per_cu < 1) { fprintf(stderr, "kernel_launch: occupancy query reports %d workgroups per CU\n", per_cu); (void)hipGetLastError(); grid = -1; return; }
        grid = cus;
    }
    if (grid < 0) return;
    (void)hipMemsetAsync((char*)d_ws + WS_CTL, 0, CTL_ZERO_BYTES, stream);
    Args a{};
    for (int i = 0; i < 19; ++i) a.in[i] = (const float*)d_in[i];
    a.out = (float*)d_out; a.ws = (unsigned char*)d_ws;
#if MK_PER_PHASE
    for (int p = 0; p < NPHASE; ++p) { a.ph_lo = p; a.ph_hi = p + 1; hipLaunchKernelGGL(fwd_mega, dim3(grid), dim3(NWAVES * 64), LDS_BYTES, stream, a); }
#else
    a.ph_lo = 0; a.ph_hi = NPHASE;
    hipLaunchKernelGGL(fwd_mega, dim3(grid), dim3(NWAVES * 64), LDS_BYTES, stream, a);
#endif
}
```
